# Optimizing an MI355X kernel written in HIP

```python
import jax, jax.numpy as jnp
from jax import lax
import numpy as np

D_MODEL = 1024
BATCH = 8
SEQ = 4096
DEPTH = 2

N_HEADS = 8
QK_NOPE = 64
QK_ROPE = 32
QK_HEAD = QK_NOPE + QK_ROPE
V_HEAD = 64
Q_LORA = 384
KV_LORA = 256
ROPE_THETA = 10000.0
Q_BLOCK = 128
CHUNK = 128
SGU_GROUPS = 8
SGU_GROUP_DIM = 64
SGU_WIDTH = SGU_GROUPS * SGU_GROUP_DIM
FNET_GROUPS = 4
FNET_GROUP_DIM = 128
FNET_WIDTH = FNET_GROUPS * FNET_GROUP_DIM
N_BRANCH = 3
IN_SPLITS = (Q_LORA, KV_LORA, QK_ROPE, 2 * SGU_WIDTH, FNET_WIDTH, N_BRANCH * D_MODEL)
N_IN = sum(IN_SPLITS)
N_GROUPS = 4
EXPERTS_PER_GROUP = 8
N_EXPERTS = N_GROUPS * EXPERTS_PER_GROUP
TOP_K = 2
D_EXPERT = 256
EPS = 1e-6

kernel_name = "hybrid_mla_sgu_fnet_hiermoe_encoder"


def rms_norm(x, g):
    xf = x.astype(jnp.float32)
    y = xf * lax.rsqrt(jnp.mean(xf * xf, axis=-1, keepdims=True) + EPS)
    return (y * g.astype(jnp.float32)).astype(x.dtype)


def layer_norm(x, g, b):
    xf = x.astype(jnp.float32)
    mu = jnp.mean(xf, axis=-1, keepdims=True)
    xc = xf - mu
    var = jnp.mean(xc * xc, axis=-1, keepdims=True)
    y = xc * lax.rsqrt(var + EPS) * g.astype(jnp.float32) + b.astype(jnp.float32)
    return y.astype(x.dtype)


def rope_tables(positions):
    inv = 1.0 / (ROPE_THETA ** (jnp.arange(0, QK_ROPE, 2, dtype=jnp.float32) / QK_ROPE))
    ang = positions.astype(jnp.float32)[..., None] * inv
    return jnp.cos(ang), jnp.sin(ang)


def apply_rope(x, cos, sin):
    xf = x.astype(jnp.float32)
    x1, x2 = jnp.split(xf, 2, axis=-1)
    c = cos[:, :, None, :]
    s = sin[:, :, None, :]
    return jnp.concatenate([x1 * c - x2 * s, x1 * s + x2 * c], axis=-1).astype(x.dtype)


def block_attention(q, k, v):
    B, S, H, Dq = q.shape
    nb = S // Q_BLOCK
    scale = QK_HEAD ** -0.5
    qb = q.reshape(B, nb, Q_BLOCK, H, Dq).transpose(1, 0, 2, 3, 4)

    def one_block(q_blk):
        s = jnp.einsum('bqhd,bkhd->bhqk', q_blk, k, preferred_element_type=jnp.float32) * scale
        p = jax.nn.softmax(s, axis=-1)
        return jnp.einsum('bhqk,bkhd->bqhd', p.astype(v.dtype), v)

    o = lax.map(one_block, qb)
    return o.transpose(1, 0, 2, 3, 4).reshape(B, S, H * V_HEAD)


def mla_branch(c_q, c_kv, k_rope, cos, sin, q_a_norm, w_uq, kv_a_norm, w_ukv, q_norm, k_norm):
    B, S, _ = c_q.shape
    q = (rms_norm(c_q, q_a_norm) @ w_uq).reshape(B, S, N_HEADS, QK_HEAD)
    kv = (rms_norm(c_kv, kv_a_norm) @ w_ukv).reshape(B, S, N_HEADS, QK_NOPE + V_HEAD)
    k_nope, v = kv[..., :QK_NOPE], kv[..., QK_NOPE:]
    k_r = jnp.broadcast_to(k_rope[:, :, None, :], (B, S, N_HEADS, QK_ROPE))
    k = jnp.concatenate([k_nope, k_r], axis=-1)
    q = rms_norm(q, q_norm)
    k = rms_norm(k, k_norm)
    q = jnp.concatenate([q[..., :QK_NOPE], apply_rope(q[..., QK_NOPE:], cos, sin)], axis=-1)
    k = jnp.concatenate([k[..., :QK_NOPE], apply_rope(k[..., QK_NOPE:], cos, sin)], axis=-1)
    return block_attention(q, k, v)


def sgu_branch(uv_pre, ln_g, ln_b, w_s, b_s):
    B, S, _ = uv_pre.shape
    uv = jax.nn.gelu(uv_pre)
    u, v = uv[..., :SGU_WIDTH], uv[..., SGU_WIDTH:]
    v = layer_norm(v, ln_g, ln_b)
    v = v.reshape(B, S // CHUNK, CHUNK, SGU_GROUPS, SGU_GROUP_DIM)
    mixed = jnp.einsum('gpq,bcqgd->bcpgd', w_s, v) + b_s.T[None, None, :, :, None]
    return u * mixed.reshape(B, S, SGU_WIDTH)


def fourier_branch(z):
    B, S, _ = z.shape
    zg = z.reshape(B, S, FNET_GROUPS, FNET_GROUP_DIM).astype(jnp.float32)
    f = jnp.real(jnp.fft.fft2(zg, axes=(1, 3), norm='ortho'))
    return f.reshape(B, S, FNET_WIDTH).astype(z.dtype)


def mixer_sublayer(x, cos, sin, attn_norm, w_in, q_a_norm, w_uq, kv_a_norm, w_ukv, q_norm, k_norm,
                   sgu_ln_g, sgu_ln_b, sgu_w, sgu_b, w_proj_attn, w_proj_sgu, w_proj_fnet, w_out):
    B, S, _ = x.shape
    h = rms_norm(x, attn_norm)
    z = h @ w_in
    cuts = [int(c) for c in np.cumsum(IN_SPLITS)[:-1]]
    c_q, c_kv, k_rope, sgu_in, fnet_in, gate_in = jnp.split(z, cuts, axis=-1)
    y_attn = mla_branch(c_q, c_kv, k_rope, cos, sin, q_a_norm, w_uq, kv_a_norm, w_ukv, q_norm, k_norm)
    y_sgu = sgu_branch(sgu_in, sgu_ln_g, sgu_ln_b, sgu_w, sgu_b)
    y_fnet = fourier_branch(fnet_in)
    gates = jax.nn.sigmoid(gate_in.astype(jnp.float32)).astype(x.dtype).reshape(B, S, N_BRANCH, D_MODEL)
    merged = (gates[:, :, 0] * (y_attn @ w_proj_attn)
              + gates[:, :, 1] * (y_sgu @ w_proj_sgu)
              + gates[:, :, 2] * (y_fnet @ w_proj_fnet))
    return x + merged @ w_out


def moe_sublayer(x, ffn_norm, w_group, b_group, w_router, b_router, w1, w3, w2):
    B, S, D = x.shape
    T = B * S
    h = rms_norm(x, ffn_norm).reshape(T, D)
    g_logits = (h @ w_group + b_group).astype(jnp.float32)
    g_prob = jax.nn.softmax(g_logits, axis=-1)
    g_sel = jnp.argmax(g_logits, axis=-1)
    g_w = jnp.take_along_axis(g_prob, g_sel[:, None], axis=-1)
    e_logits = (h @ w_router + b_router).astype(jnp.float32).reshape(T, N_GROUPS, EXPERTS_PER_GROUP)
    e_in_group = jnp.take_along_axis(e_logits, g_sel[:, None, None], axis=1)[:, 0]
    e_top, e_idx = lax.top_k(e_in_group, TOP_K)
    e_w = jax.nn.softmax(e_top, axis=-1) * g_w
    flat_idx = g_sel[:, None] * EXPERTS_PER_GROUP + e_idx
    combine = jnp.sum(jax.nn.one_hot(flat_idx, N_EXPERTS, dtype=jnp.float32) * e_w[..., None], axis=1)
    combine = combine.astype(h.dtype)
    out = jnp.zeros_like(h)
    for gi in range(N_GROUPS):
        sl = slice(gi * EXPERTS_PER_GROUP, (gi + 1) * EXPERTS_PER_GROUP)
        a = jnp.einsum('td,edf->tef', h, w1[sl])
        b = jnp.einsum('td,edf->tef', h, w3[sl])
        hid = jax.nn.silu(a) * b * combine[:, sl, None]
        out = out + jnp.einsum('tef,efd->td', hid, w2[sl])
    return x + out.reshape(B, S, D)


def setup_inputs(seed: int = 0) -> dict:
    key = jax.random.key(seed)
    ks = jax.random.split(key, 32)
    f32 = jnp.float32

    def nrm(k, shape, scale):
        return jax.random.normal(k, shape, f32) * scale

    def gain(k, shape):
        return 1.0 + 0.05 * jax.random.normal(k, shape, f32)

    L = DEPTH
    x = jax.random.normal(ks[0], (BATCH, SEQ, D_MODEL), f32)
    positions = (jnp.arange(SEQ, dtype=jnp.int32)[None, :]
                 + jax.random.randint(ks[1], (BATCH, 1), 0, 1024, dtype=jnp.int32)).astype(jnp.int32)
    return {
        "x": x,
        "positions": positions,
        "attn_norm": gain(ks[2], (L, D_MODEL)),
        "w_in": nrm(ks[3], (L, D_MODEL, N_IN), D_MODEL ** -0.5),
        "q_a_norm": gain(ks[4], (L, Q_LORA)),
        "w_uq": nrm(ks[5], (L, Q_LORA, N_HEADS * QK_HEAD), Q_LORA ** -0.5),
        "kv_a_norm": gain(ks[6], (L, KV_LORA)),
        "w_ukv": nrm(ks[7], (L, KV_LORA, N_HEADS * (QK_NOPE + V_HEAD)), KV_LORA ** -0.5),
        "q_norm": gain(ks[8], (L, QK_HEAD)),
        "k_norm": gain(ks[9], (L, QK_HEAD)),
        "sgu_ln_g": gain(ks[10], (L, SGU_WIDTH)),
        "sgu_ln_b": nrm(ks[11], (L, SGU_WIDTH), 0.02),
        "sgu_w": nrm(ks[12], (L, SGU_GROUPS, CHUNK, CHUNK), CHUNK ** -0.5),
        "sgu_b": 1.0 + nrm(ks[13], (L, SGU_GROUPS, CHUNK), 0.1),
        "w_proj_attn": nrm(ks[14], (L, N_HEADS * V_HEAD, D_MODEL), (N_HEADS * V_HEAD) ** -0.5),
        "w_proj_sgu": nrm(ks[15], (L, SGU_WIDTH, D_MODEL), SGU_WIDTH ** -0.5),
        "w_proj_fnet": nrm(ks[16], (L, FNET_WIDTH, D_MODEL), FNET_WIDTH ** -0.5),
        "w_out": nrm(ks[17], (L, D_MODEL, D_MODEL), D_MODEL ** -0.5),
        "ffn_norm": gain(ks[18], (L, D_MODEL)),
        "w_group": nrm(ks[19], (L, D_MODEL, N_GROUPS), D_MODEL ** -0.5),
        "b_group": nrm(ks[20], (L, N_GROUPS), 0.01),
        "w_router": nrm(ks[21], (L, D_MODEL, N_EXPERTS), D_MODEL ** -0.5),
        "b_router": nrm(ks[22], (L, N_EXPERTS), 0.01),
        "w1": nrm(ks[23], (L, N_EXPERTS, D_MODEL, D_EXPERT), D_MODEL ** -0.5),
        "w3": nrm(ks[24], (L, N_EXPERTS, D_MODEL, D_EXPERT), D_MODEL ** -0.5),
        "w2": nrm(ks[25], (L, N_EXPERTS, D_EXPERT, D_MODEL), D_EXPERT ** -0.5),
    }


def reference(x, positions, attn_norm, w_in, q_a_norm, w_uq, kv_a_norm, w_ukv, q_norm, k_norm,
              sgu_ln_g, sgu_ln_b, sgu_w, sgu_b, w_proj_attn, w_proj_sgu, w_proj_fnet, w_out,
              ffn_norm, w_group, b_group, w_router, b_router, w1, w3, w2):
    cos, sin = rope_tables(positions)
    for l in range(DEPTH):
        x = mixer_sublayer(x, cos, sin, attn_norm[l], w_in[l], q_a_norm[l], w_uq[l], kv_a_norm[l],
                           w_ukv[l], q_norm[l], k_norm[l], sgu_ln_g[l], sgu_ln_b[l], sgu_w[l], sgu_b[l],
                           w_proj_attn[l], w_proj_sgu[l], w_proj_fnet[l], w_out[l])
        x = moe_sublayer(x, ffn_norm[l], w_group[l], b_group[l], w_router[l], b_router[l],
                         w1[l], w3[l], w2[l])
    return x
```

```cpp
#include <hip/hip_runtime.h>
#include <cstdio>
#include <cstdint>
#include <cmath>

#ifndef MK_MULTI
#define MK_MULTI 0
#endif

#define LAS __attribute__((address_space(3)))
typedef unsigned short bf16;
typedef short bf16x8 __attribute__((ext_vector_type(8)));
typedef float f32x4 __attribute__((ext_vector_type(4)));
typedef unsigned u32x4 __attribute__((ext_vector_type(4)));
typedef unsigned u32x2 __attribute__((ext_vector_type(2)));

constexpr int D = 1024, NB = 8, SEQ = 4096, T = NB * SEQ, NL = 2;
constexpr int NH = 8, QKN = 64, QKR = 32, QKH = 96, VH = 64, QL = 384, KVL = 256;
constexpr int NIN = 5280, C_SGU = 672, C_FN = 1696, C_GATE = 2208;
constexpr int NE = 32, EPG = 8, NG = 4, DE = 256;
constexpr float EPS = 1e-6f;
constexpr int NSLOT = 73728;
__device__ constexpr float ROPE_INV[16] = {1.000000000e+00f, 5.623413324e-01f, 3.162277639e-01f, 1.778279394e-01f, 1.000000015e-01f, 5.623412877e-02f, 3.162277862e-02f, 1.778279431e-02f,
    9.999999776e-03f, 5.623413250e-03f, 3.162277862e-03f, 1.778279431e-03f, 1.000000047e-03f, 5.623413017e-04f, 3.162277862e-04f, 1.778279402e-04f};
constexpr float QSCALE = 0.10206207261596577f * 1.4426950408889634f;

constexpr size_t MiB = 1ull << 20;
constexpr size_t WS_CTL = 0, CTL_BYTES = 128 * 1024;
constexpr int CW_BAR = 4096;
constexpr int CW_CNT = 16384;
constexpr size_t WS_W = 1 * MiB;
constexpr size_t W_IN = 0;
constexpr size_t W_G = W_IN + 2304ull * 1024 * 2;
constexpr size_t W_UQ = W_G + 3072ull * 1024 * 2;
constexpr size_t W_UKV = W_UQ + 768ull * 384 * 2;
constexpr size_t W_P = W_UKV + 1024ull * 384 * 2;
constexpr size_t W_O = W_P + 1024ull * 2048 * 2;
constexpr size_t W_R = W_O + 1024ull * 1024 * 2;
constexpr size_t W_S = W_R + 256ull * 1024 * 2;
constexpr size_t W_13 = W_S + 8ull * 128 * 128 * 2;
constexpr size_t W_2 = W_13 + 32ull * 512 * 1024 * 2;
constexpr size_t W_END = W_2 + 32ull * 1024 * 256 * 2;
static_assert(W_END <= 67 * MiB, "weights region");
constexpr size_t WS_DFT = 68 * MiB;
constexpr size_t WS_ACT = 100 * MiB;
constexpr size_t A_HB = 0 * MiB;
constexpr size_t A_MERGED = 296 * MiB;
constexpr size_t A_XB = 64 * MiB;
constexpr size_t A_YAS = 64 * MiB;
constexpr size_t A_ZRI = 128 * MiB;
constexpr size_t A_HID = 128 * MiB;
constexpr size_t A_LOG = 168 * MiB;
constexpr size_t A_LAT = 192 * MiB;
constexpr size_t A_SGU = 240 * MiB;
constexpr size_t A_VT = 272 * MiB;
constexpr size_t A_ZT = 304 * MiB;
constexpr int KF = 1152;
constexpr size_t A_ZF = 336 * MiB;
constexpr size_t A_Q = 240 * MiB;
constexpr size_t A_KV = 288 * MiB;
constexpr size_t A_KB = 352 * MiB;
constexpr size_t A_GATE = 192 * MiB;
constexpr size_t A_YSLOT = 192 * MiB;
constexpr size_t ACT_END = 400 * MiB;
constexpr size_t HB8_OFF = 64 * MiB;
constexpr size_t WS_MISC = WS_ACT + ACT_END;
constexpr size_t M_RSQ = 0, M_RSKV = M_RSQ + (size_t)T * 4;
constexpr size_t M_SELE = M_RSKV + (size_t)T * 4;
constexpr size_t M_SELW = M_SELE + (size_t)T * 4;
constexpr size_t M_SELP = M_SELW + (size_t)T * 8;
constexpr size_t M_SOT = M_SELP + (size_t)T * 8;
constexpr size_t M_TOS = M_SOT + (size_t)T * 8;
constexpr size_t M_WOS = M_TOS + (size_t)NSLOT * 4;
constexpr size_t M_RSS = M_WOS + (size_t)NSLOT * 4;
constexpr size_t M_SSP = M_RSS + (size_t)NSLOT * 4;
constexpr size_t M_RS2 = M_SSP + (size_t)T * 64;
constexpr size_t M_CS = M_RS2 + (size_t)T * 4;
constexpr size_t M_SN = M_CS + (size_t)T * 64;
constexpr size_t M_GMK = M_SN + (size_t)T * 64;
constexpr size_t M_END = M_GMK + 256;
constexpr size_t WS_NEED = WS_MISC + M_END;
static_assert(WS_NEED <= 512 * MiB, "workspace");

__device__ __forceinline__ int tid_(int wv) { unsigned z = 0u; asm volatile("" : "+v"(z));
    return wv * 64 + (int)__builtin_amdgcn_mbcnt_hi(~0u, __builtin_amdgcn_mbcnt_lo(~0u, z)); }
__device__ __forceinline__ float bf2f(unsigned b) { return __uint_as_float(b << 16); }
__device__ __forceinline__ unsigned pk2(float lo, float hi) { unsigned r; asm("v_cvt_pk_bf16_f32 %0, %1, %2" : "=v"(r) : "v"(lo), "v"(hi)); return r; }
__device__ __forceinline__ unsigned f2bf(float f) { return pk2(f, 0.0f); }
__device__ __forceinline__ float wave_sum(float v) {
#pragma unroll
    for (int o = 1; o < 64; o <<= 1) v += __shfl_xor(v, o);
    return v;
}
__device__ __forceinline__ float gelu_tanh(float x) {
    const float u = 0.7978845608028654f * (x + 0.044715f * x * x * x);
    const float e = __builtin_amdgcn_exp2f(2.8853900817779268f * u);
    return x - x * __builtin_amdgcn_rcpf(e + 1.0f);
}
__device__ __forceinline__ float sigmoidf_(float x) { return __builtin_amdgcn_rcpf(1.0f + __builtin_amdgcn_exp2f(-1.4426950408889634f * x)); }
constexpr float GATE_S = 32.0f;
__device__ __forceinline__ float gate_sig(float x) { return fminf(1.0f + __builtin_amdgcn_exp2f((-1.4426950408889634f / GATE_S) * x), 1e30f); }
__device__ __forceinline__ unsigned pk4f8(float a, float b, float c, float d) { unsigned w = 0u; w = __builtin_amdgcn_cvt_pk_fp8_f32(a, b, w, false); w = __builtin_amdgcn_cvt_pk_fp8_f32(c, d, w, true); return w; }

#define XB_TMO      128
#define XB_XCNT(j)  (256  + 64 * (j))
#define XB_XSUB(j)  (1280 + 64 * (j))
#define XB_XGEN(j)  (2304 + 64 * (j))
#define XB_TOP      3328
#define XB_TOPGEN   3392
#define XCD_BAR_WORDS 3456
#define XB_SPIN_CAP (1u << 18)
__device__ __forceinline__ unsigned xb_ld(unsigned* p)              { return __hip_atomic_load(p, __ATOMIC_RELAXED, __HIP_MEMORY_SCOPE_AGENT); }
__device__ __forceinline__ unsigned xb_add(unsigned* p, unsigned v) { return __hip_atomic_fetch_add(p, v, __ATOMIC_RELAXED, __HIP_MEMORY_SCOPE_AGENT); }
__device__ __forceinline__ unsigned xb_xcc_id() { return (unsigned)__builtin_amdgcn_s_getreg((3 << 11) | 20) & 0xFu; }
#define XB_SPIN(cond, bar) do { unsigned _sp = 0; while (cond) { __builtin_amdgcn_s_sleep(1); \
    if ((++_sp & 255u) == 0u) { if (xb_ld(&(bar)[XB_TMO])) break; if (_sp > XB_SPIN_CAP) { atomicAdd(&(bar)[XB_TMO], 1u); break; } } } } while (0)
struct XcdBarrier { unsigned* bar; unsigned x; volatile LAS unsigned* st; };
__device__ __forceinline__ XcdBarrier xcd_barrier_post(unsigned* bar, volatile LAS unsigned* st, const int wv) {
    XcdBarrier b; b.bar = bar; b.x = xb_xcc_id(); b.st = st;
    if (tid_(wv) == 0) (void)xb_add(&bar[XB_XCNT(b.x)], 1u);
    return b;
}
__device__ __forceinline__ void xcd_barrier_complete(unsigned* bar, unsigned x, unsigned& nloc, unsigned& nx) {
    const unsigned G = gridDim.x * gridDim.y * gridDim.z;
    unsigned sum, cnt, mine, sp = 0u;
    for (;;) {
        sum = 0u; cnt = 0u; mine = 0u;
#pragma unroll
        for (unsigned j = 0; j < 16; ++j) { const unsigned c = xb_ld(&bar[XB_XCNT(j)]); sum += c; cnt += (c > 0u) ? 1u : 0u; mine = (j == x) ? c : mine; }
        if (sum == G) break;
        __builtin_amdgcn_s_sleep(1);
        if ((++sp & 255u) == 0u) { if (xb_ld(&bar[XB_TMO])) break; if (sp > XB_SPIN_CAP) { atomicAdd(&bar[XB_TMO], 1u); break; } }
    }
    nloc = mine > 0u ? mine : 1u; nx = cnt > 0u ? cnt : 1u;
}
__device__ __forceinline__ void xcd_barrier(const XcdBarrier& b, const int wv) {
    asm volatile("s_waitcnt vmcnt(0)" ::: "memory");
    __syncthreads();
    if (tid_(wv) == 0) {
        unsigned* bar = b.bar;
        __builtin_amdgcn_s_waitcnt(0);
        unsigned nloc = b.st[0], nx = b.st[1];
        if (nloc == 0u) { xcd_barrier_complete(bar, b.x, nloc, nx); b.st[0] = nloc; b.st[1] = nx; }
        const unsigned old = xb_add(&bar[XB_XSUB(b.x)], 1u);
        const unsigned gen = old / nloc;
        if (old + 1u == (gen + 1u) * nloc) {
            __builtin_amdgcn_fence(__ATOMIC_RELEASE, "agent");
            asm volatile("s_waitcnt vmcnt(0)" ::: "memory");
            const unsigned og = xb_add(&bar[XB_TOP], 1u);
            const unsigned tg = og / nx;
            if (og + 1u == (tg + 1u) * nx) xb_add(&bar[XB_TOPGEN], 1u);
            else XB_SPIN(xb_ld(&bar[XB_TOPGEN]) == tg, bar);
            __builtin_amdgcn_fence(__ATOMIC_ACQUIRE, "agent");
            xb_add(&bar[XB_XGEN(b.x)], 1u);
            asm volatile("s_waitcnt vmcnt(0)" ::: "memory");
        } else {
            XB_SPIN(xb_ld(&bar[XB_XGEN(b.x)]) == gen, bar);
            __builtin_amdgcn_fence(__ATOMIC_ACQUIRE, "agent");
            asm volatile("s_waitcnt vmcnt(0)" ::: "memory");
        }
    }
    __syncthreads();
}

struct Params { const float* in[26]; float* out; unsigned char* ws; int gp_lo, gp_hi; };

struct Ctx {
    const float* in[26]; float* out; unsigned char* ws; int l;
    __device__ __forceinline__ const float* inp(int i, size_t per_layer) const { return in[i] + (size_t)l * per_layer; }
    __device__ __forceinline__ bf16* w(size_t off) const { return (bf16*)(ws + WS_W + off); }
    __device__ __forceinline__ bf16* act(size_t off) const { return (bf16*)(ws + WS_ACT + off); }
    __device__ __forceinline__ unsigned char* misc(size_t off) const { return ws + WS_MISC + off; }
    __device__ __forceinline__ unsigned* ctl() const { return (unsigned*)(ws + WS_CTL); }
};

enum { K_LAT = 0, K_SGU, K_ZT, K_GATE, K_QRAW, K_KVRAW, K_FNET, K_MERGE, K_OUT, K_ROUTER, K_M1, K_M2, K_VT };
struct GU {
    const bf16* A; const bf16* B;
    const int* arow;
    int lda, ldb, K;
    int kind, r0, c0, aux;
    int chain;
};

struct Epi {
    const float* xres; const bf16* xresb;
    struct { unsigned char* ws; float* out;
        __device__ __forceinline__ bf16* act(size_t off) const { return (bf16*)(ws + WS_ACT + off); }
        __device__ __forceinline__ unsigned char* misc(size_t off) const { return ws + WS_MISC + off; } } X;
    __device__ __forceinline__ void st4(bf16* p, f32x4 v) const { u32x2 w; w.x = pk2(v[0], v[1]); w.y = pk2(v[2], v[3]); *(u32x2*)p = w; }
    struct Pre { u32x4 a, b; };
    template <unsigned KM> __device__ __forceinline__ void prefetch(const GU& u, int r, int c, Pre& P) const {
        const int row = u.r0 + r, col = u.c0 + c;
        if ((KM & (1u << K_OUT)) && u.kind == K_OUT) { const size_t o = (size_t)row * 1024 + col;
            if (xresb) { const u32x2 a = *(const u32x2*)(xresb + o), b = *(const u32x2*)(xresb + o + 128); P.a = (u32x4){a.x << 16, a.x & 0xffff0000u, a.y << 16, a.y & 0xffff0000u}; P.b = (u32x4){b.x << 16, b.x & 0xffff0000u, b.y << 16, b.y & 0xffff0000u}; }
            else { P.a = *(const u32x4*)(xres + o); P.b = *(const u32x4*)(xres + o + 128); } }
        if ((KM & ((1u << K_QRAW) | (1u << K_KVRAW))) && (u.kind == K_QRAW || u.kind == K_KVRAW)) P.a.x = __float_as_uint(((const float*)X.misc(u.kind == K_QRAW ? M_RSQ : M_RSKV))[row]);
        if ((KM & (1u << K_M1)) && u.kind == K_M1) { P.a.x = __float_as_uint(((const float*)X.misc(M_WOS))[row]); P.a.y = __float_as_uint(((const float*)X.misc(M_RSS))[row]); }
        if ((KM & (1u << K_MERGE)) && u.kind == K_MERGE) { const bf16* g = X.act(A_GATE) + (size_t)row * 768 + col + (u.aux & 3) * 256; const int nx = (u.aux & 3) < 2 ? 256 : 0;
            const u32x2 gl = *(const u32x2*)(g), gh = *(const u32x2*)(g + 128), nl = *(const u32x2*)(g + nx), nh = *(const u32x2*)(g + nx + 128);
            P.a = (u32x4){gl.x, gl.y, gh.x, gh.y}; P.b = (u32x4){nl.x, nl.y, nh.x, nh.y}; }
    }
    template <unsigned KM> __device__ __forceinline__ void run(const GU& u, int r, int c, f32x4& lo, f32x4& hi, const Pre& P) const {
        const int row = u.r0 + r, col = u.c0 + c;
        switch (u.kind) {
        case K_LAT: if (KM & (1u << K_LAT)) { bf16* p = X.act(A_LAT) + (size_t)row * 768 + col; st4(p, lo); st4(p + 128, hi); } break;
        case K_VT: if (KM & (1u << K_VT)) {
            const int b = col >> 12, pos = col & 4095;
            bf16* p = X.act(A_VT) + ((size_t)(b * 512 + row) * 4096) + pos;
            f32x4 a, b2;
#pragma unroll
            for (int j = 0; j < 4; ++j) { a[j] = gelu_tanh(lo[j]); b2[j] = gelu_tanh(hi[j]); }
            st4(p, a); st4(p + 128, b2); } break;
        case K_SGU: if (KM & (1u << K_SGU)) { bf16* p = X.act(A_SGU) + (size_t)row * 512 + col;
            f32x4 a, b;
#pragma unroll
            for (int j = 0; j < 4; ++j) { a[j] = gelu_tanh(lo[j]); b[j] = gelu_tanh(hi[j]); }
            st4(p, a); st4(p + 128, b); } break;
        case K_ZT: if (KM & (1u << K_ZT)) {
            bf16* p = X.act(A_ZT) + ((size_t)((col >> 12) * 512 + row) * 4096) + (col & 4095); st4(p, lo); st4(p + 128, hi); } break;
        case K_GATE: if (KM & (1u << K_GATE)) {
            bf16* g = X.act(A_GATE) + (size_t)row * 768 + col + u.aux * 256;
            f32x4 a, b;
#pragma unroll
            for (int j = 0; j < 4; ++j) { a[j] = gate_sig(lo[j]); b[j] = gate_sig(hi[j]); }
            st4(g, a); st4(g + 128, b); } break;
        case K_QRAW: if (KM & (1u << K_QRAW)) { bf16* p = X.act(A_Q) + (size_t)row * 768 + col; st4(p, lo); st4(p + 128, hi); } break;
        case K_KVRAW: if (KM & (1u << K_KVRAW)) { bf16* p = X.act(A_KV) + (size_t)row * 1024 + col; st4(p, lo); st4(p + 128, hi); } break;
        case K_FNET: if (KM & (1u << K_FNET)) {
            const int b = u.aux >> 2, part = (u.aux >> 1) & 1, k = 2 * row + (u.aux & 1); bf16* p = X.act(A_ZRI) + ((size_t)b * 4096 + k) * 1024 + part * 512 + col; st4(p, lo); st4(p + 128, hi);
            if (k > 0) { bf16* q = X.act(A_ZRI) + ((size_t)b * 4096 + 4096 - k) * 1024 + part * 512 + col; if (part) { st4(q, -lo); st4(q + 128, -hi); } else { st4(q, lo); st4(q + 128, hi); } } } break;
        case K_MERGE: if (KM & (1u << K_MERGE)) {
            f32x4 cl, ch_, dl, dh;
            cl[0] = bf2f(P.a.x & 0xffffu); cl[1] = bf2f(P.a.x >> 16); cl[2] = bf2f(P.a.y & 0xffffu); cl[3] = bf2f(P.a.y >> 16);
            ch_[0] = bf2f(P.a.z & 0xffffu); ch_[1] = bf2f(P.a.z >> 16); ch_[2] = bf2f(P.a.w & 0xffffu); ch_[3] = bf2f(P.a.w >> 16);
            dl[0] = bf2f(P.b.x & 0xffffu); dl[1] = bf2f(P.b.x >> 16); dl[2] = bf2f(P.b.y & 0xffffu); dl[3] = bf2f(P.b.y >> 16);
            dh[0] = bf2f(P.b.z & 0xffffu); dh[1] = bf2f(P.b.z >> 16); dh[2] = bf2f(P.b.w & 0xffffu); dh[3] = bf2f(P.b.w >> 16);
            if ((u.aux & 3) < 2) {
#pragma unroll
                for (int j = 0; j < 4; ++j) { lo[j] *= dl[j] * __builtin_amdgcn_rcpf(cl[j]); hi[j] *= dh[j] * __builtin_amdgcn_rcpf(ch_[j]); }
            } else { bf16* p = X.act(A_MERGED) + (size_t)(((u.aux >> 8) & 0xfff) * 256 + r) * 1024 + (u.aux >> 20) * 256 + c; f32x4 ol, oh;
#pragma unroll
                for (int j = 0; j < 4; ++j) { ol[j] = lo[j] * __builtin_amdgcn_rcpf(cl[j]); oh[j] = hi[j] * __builtin_amdgcn_rcpf(ch_[j]); }
                st4(p, ol); st4(p + 128, oh); } } break;
        case K_OUT: if (KM & (1u << K_OUT)) { const size_t o = (size_t)row * 1024 + col;
            const f32x4 a = __builtin_bit_cast(f32x4, P.a), b = __builtin_bit_cast(f32x4, P.b);
            *(f32x4*)(X.out + o) = a + lo; *(f32x4*)(X.out + o + 128) = b + hi; } break;
        case K_ROUTER: if (KM & (1u << K_ROUTER)) { if (col < 64) *(f32x4*)((float*)X.act(A_LOG) + (size_t)u.aux * T * 64 + (size_t)row * 64 + col) = lo; } break;
        case K_M1: if (KM & (1u << K_M1)) {
            const float wgt = __uint_as_float(P.a.x), rs = __uint_as_float(P.a.y);
            f32x4 h;
#pragma unroll
            for (int j = 0; j < 4; ++j) { const float a = lo[j] * rs; h[j] = a * sigmoidf_(a) * (hi[j] * rs) * wgt; }
            st4(X.act(A_HID) + (size_t)row * 256 + col, h); } break;
        case K_M2: if (KM & (1u << K_M2)) { bf16* p = X.act(A_YSLOT) + (size_t)row * 1024 + col; st4(p, lo); st4(p + 128, hi); } break;
        }
    }
    __device__ __forceinline__ void st8(bf16* p, f32x4 a, f32x4 b) const { u32x4 w; w.x = pk2(a[0], a[1]); w.y = pk2(a[2], a[3]); w.z = pk2(b[0], b[1]); w.w = pk2(b[2], b[3]); *(u32x4*)p = w; }
    template <unsigned KM> __device__ __forceinline__ void run8(const GU& u, int r, int c, f32x4& lo0, f32x4& lo1, f32x4& hi0, f32x4& hi1, const Pre& P0, const Pre& P1) const {
        const int row = u.r0 + r, col = u.c0 + c; bf16* p = nullptr; int act = 0;
        constexpr unsigned PLAIN = (1u << K_LAT) | (1u << K_SGU) | (1u << K_ZT) | (1u << K_VT) | (1u << K_QRAW) | (1u << K_KVRAW) | (1u << K_FNET) | (1u << K_M2);
        if ((KM & PLAIN) && ((PLAIN >> u.kind) & 1u)) {
            switch (u.kind) {
            case K_LAT: if (KM & (1u << K_LAT)) p = X.act(A_LAT) + (size_t)row * 768 + col; break;
            case K_SGU: if (KM & (1u << K_SGU)) { p = X.act(A_SGU) + (size_t)row * 512 + col; act = 1; } break;
            case K_ZT: if (KM & (1u << K_ZT)) p = X.act(A_ZT) + ((size_t)((col >> 12) * 512 + row) * 4096) + (col & 4095); break;
            case K_VT: if (KM & (1u << K_VT)) { p = X.act(A_VT) + ((size_t)((col >> 12) * 512 + row) * 4096) + (col & 4095); act = 1; } break;
            case K_QRAW: if (KM & (1u << K_QRAW)) { p = X.act(A_Q) + (size_t)row * 768 + col; act = 3; } break;
            case K_KVRAW: if (KM & (1u << K_KVRAW)) { p = X.act(A_KV) + (size_t)row * 1024 + col; act = 4; } break;
            case K_FNET: if (KM & (1u << K_FNET)) p = X.act(A_ZRI) + ((size_t)(u.aux >> 2) * 4096 + 2 * row + (u.aux & 1)) * 1024 + ((u.aux >> 1) & 1) * 512 + col; break;
            case K_M2: if (KM & (1u << K_M2)) p = X.act(A_YSLOT) + (size_t)row * 1024 + col; break;
            }
            f32x4 a0 = lo0, a1 = lo1, b0 = hi0, b1 = hi1;
            if ((KM & ((1u << K_SGU) | (1u << K_VT))) && act == 1) {
#pragma unroll
                for (int j = 0; j < 4; ++j) { a0[j] = gelu_tanh(a0[j]); a1[j] = gelu_tanh(a1[j]); b0[j] = gelu_tanh(b0[j]); b1[j] = gelu_tanh(b1[j]); } }
            if ((KM & ((1u << K_QRAW) | (1u << K_KVRAW))) && act >= 3) { const float rs = __uint_as_float(P0.a.x); a0 *= rs; a1 *= rs; b0 *= rs; b1 *= rs; }
            st8(p, a0, a1); st8(p + 128, b0, b1);
            if ((KM & (1u << K_FNET)) && u.kind == K_FNET && (2 * row + (u.aux & 1)) > 0) {
                bf16* q = X.act(A_ZRI) + ((size_t)(u.aux >> 2) * 4096 + 4096 - (2 * row + (u.aux & 1))) * 1024 + ((u.aux >> 1) & 1) * 512 + col;
                if (u.aux & 2) { a0 = -a0; a1 = -a1; b0 = -b0; b1 = -b1; }
                st8(q, a0, a1); st8(q + 128, b0, b1); }
        } else if ((KM & (1u << K_OUT)) && u.kind == K_OUT) {
            const size_t o = (size_t)row * 1024 + col;
            const f32x4 x0 = __builtin_bit_cast(f32x4, P0.a) + lo0, x1 = __builtin_bit_cast(f32x4, P1.a) + lo1, y0 = __builtin_bit_cast(f32x4, P0.b) + hi0, y1 = __builtin_bit_cast(f32x4, P1.b) + hi1;
            bf16* xb = X.act(A_XB) + o; st8(xb, x0, x1); st8(xb + 128, y0, y1);
            float ss = 0.f;
#pragma unroll
            for (int j = 0; j < 4; ++j) ss += x0[j] * x0[j] + x1[j] * x1[j] + y0[j] * y0[j] + y1[j] * y1[j];
            ss += __shfl_xor(ss, 16); ss += __shfl_xor(ss, 32);
            if ((c & 24) == 0) ((float*)X.misc(M_SSP))[(size_t)row * 16 + (u.c0 >> 8) * 4 + (c >> 5)] = ss;
        } else if ((KM & (1u << K_GATE)) && u.kind == K_GATE) {
            f32x4 a0, a1, b0, b1;
#pragma unroll
            for (int j = 0; j < 4; ++j) { a0[j] = gate_sig(lo0[j]); a1[j] = gate_sig(lo1[j]); b0[j] = gate_sig(hi0[j]); b1[j] = gate_sig(hi1[j]); }
            bf16* g = X.act(A_GATE) + (size_t)row * 768 + col + u.aux * 256;
            st8(g, a0, a1); st8(g + 128, b0, b1);
        } else { run<KM>(u, r, c, lo0, hi0, P0); run<KM>(u, r, c + 4, lo1, hi1, P1); }
    }
};

template <unsigned KM, class Sched>
__device__ __forceinline__ void gemm_naive(const Sched& S, const Epi& E, const int wv) {
    const int tid = tid_(wv); const int lane = tid & 63, wid = tid >> 6, fr = lane & 15, fq = lane >> 4;
    f32x4 acc[2][16];
    GU u;
    for (int i = 0; S.next(i, u); ++i) {
        if (!u.chain) {
#pragma unroll
            for (int mi = 0; mi < 2; ++mi)
#pragma unroll
                for (int ni = 0; ni < 16; ++ni) acc[mi][ni] = (f32x4){0.f, 0.f, 0.f, 0.f};
        }
        const bf16* ap[2];
#pragma unroll
        for (int mi = 0; mi < 2; ++mi) { const int r = 32 * wid + 16 * mi + fr; const size_t rr = u.arow ? (size_t)u.arow[r] : (size_t)r; ap[mi] = u.A + rr * u.lda + 8 * fq; }
        const bf16* bp = u.B + (size_t)fr * u.ldb + 8 * fq;
        for (int k0 = 0; k0 < u.K; k0 += 32) {
            const bf16x8 a0 = *(const bf16x8*)(ap[0] + k0), a1 = *(const bf16x8*)(ap[1] + k0);
#pragma unroll
            for (int ni = 0; ni < 16; ++ni) {
                const bf16x8 b = *(const bf16x8*)(bp + (size_t)(16 * ni) * u.ldb + k0);
                acc[0][ni] = __builtin_amdgcn_mfma_f32_16x16x32_bf16(b, a0, acc[0][ni], 0, 0, 0);
                acc[1][ni] = __builtin_amdgcn_mfma_f32_16x16x32_bf16(b, a1, acc[1][ni], 0, 0, 0);
            }
        }
#pragma unroll
        for (int mi = 0; mi < 2; ++mi)
#pragma unroll
            for (int ni = 0; ni < 8; ++ni) { Epi::Pre P; E.template prefetch<KM>(u, 32 * wid + 16 * mi + fr, 16 * ni + 4 * fq, P); E.template run<KM>(u, 32 * wid + 16 * mi + fr, 16 * ni + 4 * fq, acc[mi][ni], acc[mi][ni + 8], P); }
    }
}

constexpr int BK = 64, HTB = 128 * BK * 2;
__host__ __device__ __forceinline__ int lds_byte(int r, int c) { const int st = (r >> 4) * 2 + (c >> 5), rr = r & 15, cc = c & 31, ob = rr * 64 + cc * 2; return st * 1024 + (ob ^ (((ob >> 9) & 1) << 5)); }
__host__ __device__ __forceinline__ void stage_rc(int b, int& R, int& C) { const int st = b / 1024, sb = b % 1024, swz = sb ^ (((sb >> 9) & 1) << 5); R = (st >> 1) * 16 + swz / 64; C = (st & 1) * 32 + (swz % 64) / 2; }
__host__ __device__ __forceinline__ int perm32(int rho) { const int n = rho >> 4, i = rho & 15; return 8 * (i >> 2) + 4 * n + (i & 3); }
struct StageOff { unsigned a[2][2], b[2]; };
__device__ __forceinline__ void stage_offsets(const GU& u, const int (&R)[2], const int (&C)[2], const int (&Rb)[2], StageOff& o) {
#pragma unroll
    for (int i = 0; i < 2; ++i) {
        o.b[i] = (unsigned)(Rb[i] * u.ldb + C[i]) * 2u;
#pragma unroll
        for (int h = 0; h < 2; ++h) { const int row = R[i] + 128 * h; const int sr = u.arow ? u.arow[row] : row; o.a[h][i] = (unsigned)(sr * u.lda + C[i]) * 2u; }
    }
}
template <unsigned KM, bool VAR, class Sched>
__device__ __forceinline__ void gemm_fast(LAS unsigned char* lds, const Sched& S, const Epi& E, const int wv) {
    const int tid = tid_(wv); const int wid = __builtin_amdgcn_readfirstlane(tid >> 6), lane = tid & 63, wr = wid >> 2, wc = wid & 3, fr = lane & 15, fq = lane >> 4;
    int R[2], C[2], Rb[2];
#pragma unroll
    for (int i = 0; i < 2; ++i) { stage_rc(tid * 16 + i * 8192, R[i], C[i]); Rb[i] = (R[i] & ~31) + perm32(R[i] & 31); }
    const size_t kstep = (size_t)(BK * 2);
    const unsigned ldsw = (unsigned)wid * 1024u;
    const int aoff = lds_byte(wr * 64 + fr, fq * 8), boff = lds_byte(wc * 32 + fr, fq * 8);
#define PG8_SA(b, h) (((b) * 2 + (h)) * HTB)
#define PG8_SB(b, h) ((4 + (b) * 2 + (h)) * HTB)
#define PG8_STAGE2(bufoff, gbase, v0, v1) do { \
        __builtin_amdgcn_global_load_lds((const unsigned*)((const char*)(gbase) + (v0)), (LAS unsigned*)(lds + (bufoff) + ldsw), 16, 0, 0); \
        __builtin_amdgcn_global_load_lds((const unsigned*)((const char*)(gbase) + (v1)), (LAS unsigned*)(lds + (bufoff) + ldsw + 8192), 16, 0, 0); } while (0)
#define PG8_LDA(dst, b, h) do { _Pragma("unroll") for (int m = 0; m < 4; ++m) _Pragma("unroll") for (int k = 0; k < 2; ++k) dst[m][k] = *(const LAS bf16x8*)(lds + PG8_SA(b, h) + aoff + m * 2048 + k * 1024); } while (0)
#define PG8_LDB(dst, b, h) do { _Pragma("unroll") for (int n = 0; n < 2; ++n) _Pragma("unroll") for (int k = 0; k < 2; ++k) dst[n][k] = *(const LAS bf16x8*)(lds + PG8_SB(b, h) + boff + n * 2048 + k * 1024); } while (0)
#define PG8_MMA(ai, bj, At, Bt) do { __builtin_amdgcn_s_setprio(1); _Pragma("unroll") for (int m = 0; m < 4; ++m) _Pragma("unroll") for (int n = 0; n < 2; ++n) _Pragma("unroll") for (int k = 0; k < 2; ++k) \
        acc[ai][bj][m][n] = __builtin_amdgcn_mfma_f32_16x16x32_bf16(Bt[n][k], At[m][k], acc[ai][bj][m][n], 0, 0, 0); __builtin_amdgcn_s_setprio(0); } while (0)
    typedef int i32x4_ __attribute__((ext_vector_type(4))); typedef int i32x8_ __attribute__((ext_vector_type(8)));
    constexpr bool F8 = (KM == (1u << K_GATE));
#define PG8_CAT(X0, X1) __builtin_shufflevector(__builtin_bit_cast(i32x4_, X0), __builtin_bit_cast(i32x4_, X1), 0, 1, 2, 3, 4, 5, 6, 7)
#define PG8_MMA8(ai, bj, At, Bt) do { __builtin_amdgcn_s_setprio(1); _Pragma("unroll") for (int m = 0; m < 4; ++m) _Pragma("unroll") for (int n = 0; n < 2; ++n) \
        { const i32x8_ b8_ = PG8_CAT(Bt[n][0], Bt[n][1]), a8_ = PG8_CAT(At[m][0], At[m][1]); asm volatile("v_mfma_f32_16x16x128_f8f6f4 %0, %1, %2, %0" : "+v"(acc[ai][bj][m][n]) : "v"(b8_), "v"(a8_)); }      \
        __builtin_amdgcn_s_setprio(0); } while (0)
#define PG8_MM(ai, bj, At, Bt) do { if (F8) PG8_MMA8(ai, bj, At, Bt); else PG8_MMA(ai, bj, At, Bt); } while (0)
#define PG8_WAIT_V(n) asm volatile("s_waitcnt vmcnt(" #n ")" ::: "memory")
#define PG8_WAIT_L(n) asm volatile("s_waitcnt lgkmcnt(" #n ")" ::: "memory")
#define PG8_BAR __builtin_amdgcn_s_barrier()
#define PG8_SCHED __builtin_amdgcn_sched_barrier(0)
    GU cur, nxt; int ui = 0;
    if (!S.next(0, cur)) return;
    StageOff co, no;
    stage_offsets(cur, R, C, Rb, co);
    f32x4 acc[2][2][4][2];
#pragma unroll
    for (int a = 0; a < 2; ++a)
#pragma unroll
        for (int b = 0; b < 2; ++b)
#pragma unroll
            for (int m = 0; m < 4; ++m)
#pragma unroll
                for (int n = 0; n < 2; ++n) acc[a][b][m][n] = (f32x4){0.f, 0.f, 0.f, 0.f};
    bf16x8 At[4][2], B0[2][2], B1[2][2];
    const char* cA = (const char*)cur.A; const char* cB = (const char*)cur.B; size_t chB = (size_t)cur.ldb * 256;
    PG8_STAGE2(PG8_SB(0, 0), cB, co.b[0], co.b[1]); PG8_STAGE2(PG8_SB(0, 1), cB + chB, co.b[0], co.b[1]); PG8_STAGE2(PG8_SA(0, 0), cA, co.a[0][0], co.a[0][1]); PG8_STAGE2(PG8_SA(0, 1), cA, co.a[1][0], co.a[1][1]);
    if (wr == 1) PG8_BAR;
    PG8_WAIT_V(2); PG8_BAR;
    PG8_STAGE2(PG8_SB(1, 0), cB + kstep, co.b[0], co.b[1]); PG8_STAGE2(PG8_SA(1, 0), cA + kstep, co.a[0][0], co.a[0][1]); PG8_STAGE2(PG8_SB(1, 1), cB + chB + kstep, co.b[0], co.b[1]);
    PG8_WAIT_V(6); PG8_BAR;
    for (;;) {
        const bool has_next = S.next(ui + 1, nxt);
        const char* nA = cA; const char* nB = cB; size_t nhB = chB; if (VAR) no = co;
        if (has_next) { nA = (const char*)nxt.A; nB = (const char*)nxt.B; if (VAR) { nhB = (size_t)nxt.ldb * 256; stage_offsets(nxt, R, C, Rb, no); } }
        const int nt = cur.K / BK;
#pragma nounroll
        for (int t = 0; t < nt; t += 2) {
            const bool last = (t == nt - 2);
            const char* a1 = cA + (size_t)(t + 1) * kstep;
            const char* a2 = last ? nA : cA + (size_t)(t + 2) * kstep; const char* b2 = last ? nB : cB + (size_t)(t + 2) * kstep;
            const char* a3 = a2 + kstep; const char* b3 = b2 + kstep;
            const size_t h2 = (VAR && last) ? nhB : chB;
            const unsigned va00 = (VAR && last) ? no.a[0][0] : co.a[0][0], va01 = (VAR && last) ? no.a[0][1] : co.a[0][1], va10 = (VAR && last) ? no.a[1][0] : co.a[1][0], va11 = (VAR && last) ? no.a[1][1] : co.a[1][1];
            const unsigned vb0 = (VAR && last) ? no.b[0] : co.b[0], vb1 = (VAR && last) ? no.b[1] : co.b[1];
            PG8_LDB(B0, 0, 0); PG8_LDB(B1, 0, 1); PG8_SCHED; PG8_LDA(At, 0, 0); PG8_STAGE2(PG8_SA(1, 1), a1, co.a[1][0], co.a[1][1]);
            PG8_WAIT_V(8); PG8_WAIT_L(0); PG8_BAR; PG8_MM(0, 0, At, B0); PG8_MM(0, 1, At, B1); PG8_BAR; PG8_SCHED;
            PG8_LDA(At, 0, 1); PG8_STAGE2(PG8_SB(0, 0), b2, vb0, vb1); PG8_STAGE2(PG8_SB(0, 1), b2 + h2, vb0, vb1); PG8_STAGE2(PG8_SA(0, 0), a2, va00, va01);
            PG8_WAIT_V(8); PG8_WAIT_L(0); PG8_BAR; PG8_MM(1, 0, At, B0); PG8_MM(1, 1, At, B1); PG8_BAR; PG8_SCHED;
            PG8_LDB(B0, 1, 0); PG8_LDB(B1, 1, 1); PG8_SCHED; PG8_LDA(At, 1, 0); PG8_STAGE2(PG8_SA(0, 1), a2, va10, va11);
            PG8_WAIT_V(8); PG8_WAIT_L(0); PG8_BAR; PG8_MM(0, 0, At, B0); PG8_MM(0, 1, At, B1); PG8_BAR; PG8_SCHED;
            PG8_LDA(At, 1, 1); PG8_STAGE2(PG8_SB(1, 0), b3, vb0, vb1); PG8_STAGE2(PG8_SB(1, 1), b3 + h2, vb0, vb1); PG8_STAGE2(PG8_SA(1, 0), a3, va00, va01);
            PG8_WAIT_V(8); PG8_WAIT_L(0); PG8_BAR; PG8_MM(1, 0, At, B0); PG8_MM(1, 1, At, B1); PG8_BAR; PG8_SCHED;
        }
        if (wr == 0) PG8_BAR;
        if (F8) asm volatile("s_nop 15\n\ts_nop 15" ::: "memory");
#pragma unroll
        for (int ai = 0; ai < 2; ++ai) {
            Epi::Pre P[4][2];
#pragma unroll
            for (int m = 0; m < 4; ++m)
#pragma unroll
                for (int n = 0; n < 2; ++n) E.template prefetch<KM>(cur, 128 * ai + 64 * wr + 16 * m + fr, 32 * wc + 8 * fq + 4 * n, P[m][n]);
            if (KM & ((1u << K_QRAW) | (1u << K_KVRAW) | (1u << K_M1))) {
#pragma unroll
                for (int m = 0; m < 4; ++m) { asm volatile("" : "+v"(P[m][0].a.x), "+v"(P[m][0].a.y)); if (KM & (1u << K_M1)) asm volatile("" : "+v"(P[m][1].a.x), "+v"(P[m][1].a.y)); }
            }
            if (KM & ((1u << K_OUT) | (1u << K_MERGE))) {
#pragma unroll
                for (int m = 0; m < 4; ++m)
#pragma unroll
                    for (int n = 0; n < 2; ++n) asm volatile("" : "+v"(P[m][n].a), "+v"(P[m][n].b));
            }
#pragma unroll
            for (int m = 0; m < 4; ++m) { E.template run8<KM>(cur, 128 * ai + 64 * wr + 16 * m + fr, 32 * wc + 8 * fq, acc[ai][0][m][0], acc[ai][0][m][1], acc[ai][1][m][0], acc[ai][1][m][1], P[m][0], P[m][1]);
                asm volatile("" ::: "memory"); }
        }
        if (!has_next) break;
        if (!nxt.chain) {
#pragma unroll
            for (int a = 0; a < 2; ++a)
#pragma unroll
                for (int b = 0; b < 2; ++b)
#pragma unroll
                    for (int m = 0; m < 4; ++m)
#pragma unroll
                        for (int n = 0; n < 2; ++n) acc[a][b][m][n] = (f32x4){0.f, 0.f, 0.f, 0.f};
        }
        cur = nxt; cA = nA; cB = nB; if (VAR) { chB = nhB; co = no; } ++ui;
        if (wr == 1) PG8_BAR;
    }
    PG8_WAIT_V(0);
    PG8_BAR;
#undef PG8_SA
#undef PG8_SB
#undef PG8_STAGE2
#undef PG8_LDA
#undef PG8_LDB
#undef PG8_MMA
#undef PG8_MMA8
#undef PG8_MM
#undef PG8_CAT
#undef PG8_WAIT_V
#undef PG8_WAIT_L
#undef PG8_BAR
#undef PG8_SCHED
}

__device__ __forceinline__ void order_map(int L, int nM, int nN, int& pm, int& pn) {
    const int nwg = nM * nN; int wgid = L;
    { const int q = nwg / 8, r = nwg % 8, xcd = wgid % 8, off = wgid / 8; wgid = (xcd < r ? xcd * (q + 1) : r * (q + 1) + (xcd - r) * q) + off; }
    const int nig = 8 * nN, gid = wgid / nig, fm = gid * 8, gsz = (nM - fm) < 8 ? (nM - fm) : 8;
    pm = fm + ((wgid % nig) % gsz); pn = (wgid % nig) / gsz;
}
struct SchedG1A {
    const bf16 *hb, *win; int G, c;
    __device__ __forceinline__ bool next(int i, GU& u) const {
        const int L = i * G + c; if (L >= 128 * 9) return false;
        u.arow = nullptr; u.lda = 1024; u.ldb = 1024; u.K = 1024; u.chain = 0; u.aux = 0;
        int pm, j; order_map(L, 128, 9, pm, j);
        if (j < 5) { u.A = hb + (size_t)pm * 256 * 1024; u.B = win + (size_t)j * 256 * 1024; u.r0 = pm * 256;
            if (j < 3) { u.kind = K_LAT; u.c0 = j * 256; } else { u.kind = K_SGU; u.c0 = (j - 3) * 256; } }
        else { u.A = win + (size_t)j * 256 * 1024; u.B = hb + (size_t)pm * 256 * 1024; u.c0 = pm * 256;
            if (j < 7) { u.kind = K_VT; u.r0 = (j - 5) * 256; } else { u.kind = K_ZT; u.r0 = (j - 7) * 256; } }
        return true;
    }
};
struct SchedG34 { const bf16 *lat, *wuq, *wukv; int G, c;
    __device__ __forceinline__ bool next(int i, GU& u) const {
        const int L = i * G + c; if (L >= 128 * 7) return false;
        int pm, pn; order_map(L, 128, 7, pm, pn);
        u.arow = nullptr; u.lda = 768; u.chain = 0; u.aux = 0; u.r0 = pm * 256;
        if (pn < 3) { u.A = lat + (size_t)pm * 256 * 768; u.B = wuq + (size_t)pn * 256 * 384; u.ldb = 384; u.K = 384; u.kind = K_QRAW; u.c0 = pn * 256; }
        else { u.A = lat + (size_t)pm * 256 * 768 + 384; u.B = wukv + (size_t)(pn - 3) * 256 * 384; u.ldb = 384; u.K = 256; u.kind = K_KVRAW; u.c0 = (pn - 3) * 256; }
        return true;
    }
};
struct SchedF2 { const bf16 *dft, *zf; int G, c;
    __device__ __forceinline__ bool next(int i, GU& u) const {
        const int L = i * G + c; if (L >= 256) return false;
        const int b = L & 7, idx = L >> 3, ty = idx >> 3, pm = (idx >> 1) & 3, pn = idx & 1;
        u.arow = nullptr; u.lda = KF; u.ldb = KF; u.K = KF; u.chain = 0; u.aux = 4 * b + ty; u.kind = K_FNET;
        u.A = dft + ((size_t)ty * 1024 + pm * 256) * KF; u.B = zf + ((size_t)(b * 4 + ty) * 512 + pn * 256) * KF; u.r0 = pm * 256; u.c0 = pn * 256; return true;
    }
};
struct SchedF2G34 { SchedF2 f; SchedG34 g; int G, c;
    __device__ __forceinline__ bool next(int i, GU& u) const {
        const int L = i * G + c;
        if (L < 256) { SchedF2 f1 = f; f1.G = 1; f1.c = 0; return f1.next(L, u); }
        SchedG34 g1 = g; g1.G = 1; g1.c = 0; return g1.next(L - 256, u);
    }
};
struct SchedGate { const bf16 *hb, *wg; int L, gr;
    __device__ __forceinline__ bool next(int i, GU& u) const {
        if (i >= 3) return false;
        int pm, pn; order_map(L, 128, 4, pm, pn);
        u.arow = nullptr; u.lda = 512; u.ldb = 512; u.r0 = gr; u.c0 = 0; u.K = 512; u.chain = 0; u.aux = i; u.kind = K_GATE;
        u.A = hb + (size_t)pm * 256 * 512; u.B = wg + ((size_t)i * 1024 + pn * 256) * 512; return true;
    }
};
struct SchedMerge { const bf16 *yas, *zri, *wp; int L, gr;
    __device__ __forceinline__ bool next(int i, GU& u) const {
        if (i >= 3) return false;
        int pm, pn; order_map(L, 128, 4, pm, pn);
        u.arow = nullptr; u.lda = 1024; u.ldb = 1024; u.r0 = gr; u.c0 = 0; u.K = i == 2 ? 1024 : 512; u.chain = i > 0; u.aux = i | (pm << 8) | (pn << 20); u.kind = K_MERGE;
        u.A = (i == 2 ? zri : yas + i * 512) + (size_t)pm * 256 * 1024; u.B = wp + (i == 2 ? (size_t)1024 * 1024 : (size_t)i * 512) + (size_t)pn * 256 * 1024; return true;
    }
};
struct SchedG6 { const bf16 *a, *w; int G, c; int kind, ntn;
    __device__ __forceinline__ bool next(int i, GU& u) const {
        const int L = i * G + c; if (L >= 128 * ntn) return false;
        int pm, pn; order_map(L, 128, ntn, pm, pn);
        u.arow = nullptr; u.lda = 1024; u.ldb = 1024; u.K = 1024; u.chain = 0; u.aux = 0; u.kind = kind;
        u.A = a + (size_t)pm * 256 * 1024; u.B = w + (size_t)pn * 256 * 1024; u.r0 = pm * 256; u.c0 = pn * 256; return true;
    }
};
struct SchedRT { const bf16 *xb, *wr; int G, c;
    __device__ __forceinline__ bool next(int i, GU& u) const {
        const int L = i * G + c; if (L >= 256) return false;
        const int pm = L >> 1, kh = L & 1;
        u.arow = nullptr; u.lda = 1024; u.ldb = 1024; u.K = 512; u.chain = 0; u.aux = kh; u.kind = K_ROUTER;
        u.A = xb + (size_t)pm * 256 * 1024 + kh * 512; u.B = wr + kh * 512; u.r0 = pm * 256; u.c0 = 0; return true;
    }
};
struct SchedM1 { const bf16 *h2, *w13; const int* tos; const LAS int* tb; int G, c;
    __device__ __forceinline__ bool next(int i, GU& u) const {
        const int L = i * G + c; const int nt = __builtin_amdgcn_readfirstlane(tb[32]); if (L >= nt * 2) return false;
        const int rt = L >> 1, pn = L & 1; const int e = __builtin_amdgcn_readfirstlane(tb[64 + rt]);
        u.arow = tos + rt * 256; u.A = h2; u.lda = 1024; u.B = w13 + ((size_t)e * 512 + pn * 256) * 1024; u.ldb = 1024; u.K = 1024; u.chain = 0; u.aux = e; u.kind = K_M1;
        u.r0 = rt * 256; u.c0 = pn * 128; return true;
    }
};
struct SchedM2 { const bf16 *hid, *w2; const LAS int* tb; int G, c;
    __device__ __forceinline__ bool next(int i, GU& u) const {
        const int L = i * G + c; const int nt = __builtin_amdgcn_readfirstlane(tb[32]); if (L >= nt * 4) return false;
        const int rt = L >> 2, pn = L & 3; const int e = __builtin_amdgcn_readfirstlane(tb[64 + rt]);
        u.arow = nullptr; u.A = hid + (size_t)rt * 256 * 256; u.lda = 256; u.B = w2 + ((size_t)e * 1024 + pn * 256) * 256; u.ldb = 256; u.K = 256; u.chain = 0; u.aux = e; u.kind = K_M2;
        u.r0 = rt * 256; u.c0 = pn * 256; return true;
    }
};

template <class F>
__device__ __forceinline__ void cvt_rows(bf16* dst, int nrows, int K, int gtid, int gsz, F src) {
    const int kg = K >> 3; const int total = nrows * kg;
    for (int it = gtid; it < total; it += gsz) {
        const int n = it % nrows, k0 = (it / nrows) * 8;
        u32x4 o; o.x = pk2(src(n, k0), src(n, k0 + 1)); o.y = pk2(src(n, k0 + 2), src(n, k0 + 3)); o.z = pk2(src(n, k0 + 4), src(n, k0 + 5)); o.w = pk2(src(n, k0 + 6), src(n, k0 + 7));
        *(u32x4*)(dst + (size_t)n * K + k0) = o;
    }
}
template <bool F8 = false>
__device__ __forceinline__ void tr_item(const float* src, int ld, const float* gain, bf16* dst, int dld, LAS float* scr, int lane) {
    const int c32 = lane & 31, h = lane >> 5;
    if (src) {
        float v[32];
#pragma unroll
        for (int i = 0; i < 32; ++i) v[i] = src[(size_t)(2 * i + h) * ld + c32];
#pragma unroll
        for (int i = 0; i < 32; ++i) scr[(2 * i + h) * 33 + c32] = v[i];
    } else {
#pragma unroll 8
        for (int i = 0; i < 32; ++i) scr[(2 * i + h) * 33 + c32] = 0.f;
    }
    asm volatile("s_waitcnt lgkmcnt(0)" ::: "memory");
    const int c = lane & 7;
    float g8[8];
#pragma unroll
    for (int q = 0; q < 8; ++q) g8[q] = gain ? gain[8 * c + q] : 1.0f;
#pragma unroll
    for (int j = 0; j < 4; ++j) { const int n = (lane >> 3) + 8 * j; const LAS float* sp = scr + (8 * c) * 33 + n;
        if (F8) { u32x2 o8; o8.x = pk4f8(sp[0 * 33] * GATE_S, sp[1 * 33] * GATE_S, sp[2 * 33] * GATE_S, sp[3 * 33] * GATE_S); o8.y = pk4f8(sp[4 * 33] * GATE_S, sp[5 * 33] * GATE_S, sp[6 * 33] * GATE_S, sp[7 * 33] * GATE_S);
            *(u32x2*)((unsigned char*)dst + (size_t)n * dld + 8 * c) = o8; continue; }
        u32x4 o; o.x = pk2(sp[0 * 33] * g8[0], sp[1 * 33] * g8[1]); o.y = pk2(sp[2 * 33] * g8[2], sp[3 * 33] * g8[3]); o.z = pk2(sp[4 * 33] * g8[4], sp[5 * 33] * g8[5]); o.w = pk2(sp[6 * 33] * g8[6], sp[7 * 33] * g8[7]);
        *(u32x4*)(dst + (size_t)n * dld + 8 * c) = o; }
    asm volatile("s_waitcnt lgkmcnt(0)" ::: "memory");
}
__device__ __forceinline__ void phase_weights(const Ctx& X, LAS unsigned char* lds, const int wv) {
    const int tid = tid_(wv); const int lane = tid & 63, wid = tid >> 6;
    const int gtid = blockIdx.x * blockDim.x + tid, gsz = gridDim.x * blockDim.x, gw = gtid >> 6, ngw = gsz >> 6;
    LAS float* scr = (LAS float*)(lds) + wid * (64 * 33);
    LAS float* wt = (LAS float*)(lds + 69632);
    LAS float* ct128 = (LAS float*)(lds + 86528);
    LAS float* ct4096 = (LAS float*)(lds + 87040);
    const float* w_in = X.inp(3, (size_t)D * NIN);
    if (gtid == 0) { const float* kn = X.inp(9, QKH); float g = 0.f; for (int i = 0; i < QKH; ++i) g = fmaxf(g, fabsf(kn[i])); ((float*)X.misc(M_GMK))[X.l] = 9.797958971f * g; }
    int base = 0;
#define SEG(nitems) for (int it = (((gw - base) % ngw) + ngw) % ngw, _n = (nitems), _once = (base += _n, 0); it < _n; it += ngw)
    SEG(16 * 72) { const int kb = it / 72, nb = it % 72; const int n0 = nb * 32; const int sc = n0 < 672 ? n0 : (n0 < 768 ? -1 : n0 - 768 + C_SGU);
        tr_item(sc < 0 ? nullptr : w_in + (size_t)(kb * 64) * NIN + sc, NIN, nullptr, X.w(W_IN) + (size_t)n0 * 1024 + kb * 64, 1024, scr, lane); }
    SEG(16 * 96) { const int kb = it / 96, nb = it % 96;
        tr_item<true>(w_in + (size_t)(kb * 64) * NIN + C_GATE + nb * 32, NIN, nullptr, (bf16*)((unsigned char*)X.w(W_G) + (size_t)(nb * 32) * 1024 + kb * 64), 1024, scr, lane); }
    { const float* w = X.inp(5, (size_t)QL * 768); const float* g = X.inp(4, QL);
      SEG(6 * 24) { const int kb = it / 24, nb = it % 24; tr_item(w + (size_t)(kb * 64) * 768 + nb * 32, 768, g + kb * 64, X.w(W_UQ) + (size_t)(nb * 32) * 384 + kb * 64, 384, scr, lane); } }
    { const float* w = X.inp(7, (size_t)KVL * 1024); const float* g = X.inp(6, KVL);
      SEG(6 * 32) { const int kb = it / 32, nb = it % 32; tr_item(kb < 4 ? w + (size_t)(kb * 64) * 1024 + nb * 32 : nullptr, 1024, kb < 4 ? g + kb * 64 : nullptr, X.w(W_UKV) + (size_t)(nb * 32) * 384 + kb * 64, 384, scr, lane); } }
    for (int br = 0; br < 2; ++br) { const float* w = X.inp(14 + br, (size_t)512 * 1024);
      SEG(8 * 32) { const int kb = it / 32, nb = it % 32; tr_item(w + (size_t)(kb * 64) * 1024 + nb * 32, 1024, nullptr, X.w(W_P) + (size_t)(nb * 32) * 1024 + br * 512 + kb * 64, 1024, scr, lane); } }
    { const float* w = X.inp(17, (size_t)1024 * 1024);
      SEG(16 * 32) { const int kb = it / 32, nb = it % 32; tr_item(w + (size_t)(kb * 64) * 1024 + nb * 32, 1024, nullptr, X.w(W_O) + (size_t)(nb * 32) * 1024 + kb * 64, 1024, scr, lane); } }
    { const float* w1 = X.inp(23, (size_t)NE * D * DE); const float* w3 = X.inp(24, (size_t)NE * D * DE);
      SEG(32 * 16 * 16) { const int e = it >> 8, kb = (it >> 4) & 15, nb = it & 15; const int r = nb * 32, pn = r >> 8, half = (r >> 7) & 1, i0 = r & 127;
          const float* w = (half ? w3 : w1) + ((size_t)e * D + kb * 64) * DE + pn * 128 + i0;
          tr_item(w, DE, X.inp(18, D) + kb * 64, X.w(W_13) + ((size_t)e * 512 + r) * 1024 + kb * 64, 1024, scr, lane); } }
    { const float* w2 = X.inp(25, (size_t)NE * DE * D);
      SEG(32 * 4 * 32) { const int e = it >> 7, kb = (it >> 5) & 3, nb = it & 31;
          tr_item(w2 + ((size_t)e * DE + kb * 64) * D + nb * 32, D, nullptr, X.w(W_2) + ((size_t)e * 1024 + nb * 32) * 256 + kb * 64, 256, scr, lane); } }
#undef SEG
    { const float* wg = X.inp(19, (size_t)D * NG); const float* wr = X.inp(21, (size_t)D * NE); const float* fg = X.inp(18, D);
      cvt_rows(X.w(W_R), 256, 1024, gtid, gsz, [&](int n, int k) { return n < 4 ? wg[(size_t)k * NG + n] * fg[k] : (n < 36 ? wr[(size_t)k * NE + (n - 4)] * fg[k] : 0.f); }); }
    { const float* w = X.inp(12, (size_t)8 * 128 * 128);
      for (int it = gtid; it < 8 * 128 * 128 / 8; it += gsz) { const float* sp = w + (size_t)it * 8; u32x4 o; o.x = pk2(sp[0], sp[1]); o.y = pk2(sp[2], sp[3]); o.z = pk2(sp[4], sp[5]); o.w = pk2(sp[6], sp[7]); *(u32x4*)(X.w(W_S) + (size_t)it * 8) = o; } }
    for (int i = tid; i < 128; i += 512) ct128[i] = cospif((float)i / 64.0f);
    if (X.l == 0) for (int i = tid; i < 4096; i += 512) ct4096[i] = cospif((float)i / 2048.0f) * 0.015625f;
    { const float* wpf = X.inp(16, (size_t)512 * 1024);
      for (int item = blockIdx.x; item < 4 * 32; item += gridDim.x) {
        const int g = item >> 5, n0 = (item & 31) * 32;
        __syncthreads();
        for (int i = tid; i < 128 * 32; i += 512) { const int jp = i >> 5, n = i & 31; wt[jp * 33 + n] = wpf[(size_t)(g * 128 + jp) * 1024 + n0 + n]; }
        __syncthreads();
#pragma unroll
        for (int rr = 0; rr < 2; ++rr) {
            const int idx = tid + 512 * rr, n = idx & 31, jg = (idx >> 5) & 15, part = idx >> 9, sh = part ? 96 : 0;
            float a[8] = {0.f, 0.f, 0.f, 0.f, 0.f, 0.f, 0.f, 0.f};
#pragma unroll 4
            for (int jp = 0; jp < 128; ++jp) { const float w = wt[jp * 33 + n];
#pragma unroll
                for (int q = 0; q < 8; ++q) a[q] += w * ct128[((jg * 8 + q) * jp + sh) & 127]; }
            const float sc = 0.08838834764831845f;
            u32x4 o; o.x = pk2(a[0] * sc, a[1] * sc); o.y = pk2(a[2] * sc, a[3] * sc); o.z = pk2(a[4] * sc, a[5] * sc); o.w = pk2(a[6] * sc, a[7] * sc);
            *(u32x4*)(X.w(W_P) + (size_t)1024 * 1024 + (size_t)(n0 + n) * 1024 + part * 512 + g * 128 + jg * 8) = o;
        }
      } }
    if (X.l == 0) {
        const int* pos = (const int*)X.in[1]; float* cst = (float*)X.misc(M_CS); float* snt = (float*)X.misc(M_SN);
        for (int it = gtid; it < T * 16; it += gsz) { float sv, cv; sincosf((float)pos[it >> 4] * ROPE_INV[it & 15], &sv, &cv); cst[it] = cv; snt[it] = sv; }
    }
    if (X.l == 0) {
        __syncthreads();
        bf16* dft = (bf16*)(X.ws + WS_DFT);
        for (int it = gtid; it < 4 * 1024 * (KF / 8); it += gsz) {
            const int ty = it / (1024 * (KF / 8)), r = it % (1024 * (KF / 8)), jj = r / (KF / 8), n0 = (r % (KF / 8)) * 8; const int kk = 2 * jj + (ty & 1), sh = (ty >> 1) ? 1024 : 0;
            float v[8];
#pragma unroll
            for (int q = 0; q < 8; ++q) { const int m = n0 + q; v[q] = m <= 1024 ? ct4096[(kk * m + sh) & 4095] : 0.f; }
            u32x4 o; o.x = pk2(v[0], v[1]); o.y = pk2(v[2], v[3]); o.z = pk2(v[4], v[5]); o.w = pk2(v[6], v[7]);
            *(u32x4*)(dft + ((size_t)ty * 1024 + jj) * KF + n0) = o;
        }
    }
    __syncthreads();
}

__device__ __forceinline__ void phase_norm(const Ctx& X, const float* xin, int mode, const float* gain, bf16* hb, unsigned char* hb8, const int wv) {
    constexpr int R = 4;
    const int tid = tid_(wv); const int lane = tid & 63, gw = (blockIdx.x * blockDim.x + tid) >> 6, ngw = (gridDim.x * blockDim.x) >> 6;
    const int* sot = (const int*)X.misc(M_SOT); const bf16* ys = X.act(A_YSLOT);
    const float* src = mode ? (const float*)X.out : xin; const bf16* xbs = X.act(A_XB);
    for (int t0 = gw; t0 < T; t0 += R * ngw) {
        f32x4 v[R][4]; int s0[R], s1[R];
#pragma unroll
        for (int r = 0; r < R; ++r) { const int t = t0 + r * ngw; s0[r] = 0; s1[r] = 0; if (mode == 1 && t < T) { s0[r] = sot[2 * t]; s1[r] = sot[2 * t + 1]; } }
#pragma unroll
        for (int r = 0; r < R; ++r) { const int t = t0 + r * ngw; if (t < T) {
            if (mode == 1) { const u32x2* xr = (const u32x2*)(xbs + (size_t)t * D) + lane;
#pragma unroll
                for (int j = 0; j < 4; ++j) { const u32x2 a = xr[64 * j]; v[r][j] = (f32x4){bf2f(a.x & 0xffffu), bf2f(a.x >> 16), bf2f(a.y & 0xffffu), bf2f(a.y >> 16)}; } }
            else { const f32x4* xr = (const f32x4*)(src + (size_t)t * D) + lane;
#pragma unroll
                for (int j = 0; j < 4; ++j) v[r][j] = xr[64 * j]; } } }
        if (mode == 1) {
            u32x2 ya[R][4], yb[R][4];
#pragma unroll
            for (int r = 0; r < R; ++r) { const int t = t0 + r * ngw; if (t < T) { const u32x2* y0 = (const u32x2*)(ys + (size_t)s0[r] * D) + lane; const u32x2* y1 = (const u32x2*)(ys + (size_t)s1[r] * D) + lane;
#pragma unroll
                for (int j = 0; j < 4; ++j) { ya[r][j] = y0[64 * j]; yb[r][j] = y1[64 * j]; } } }
#pragma unroll
            for (int r = 0; r < R; ++r) { const int t = t0 + r * ngw; if (t < T) {
#pragma unroll
                for (int j = 0; j < 4; ++j) { const u32x2 a = ya[r][j], b = yb[r][j];
                    v[r][j][0] += bf2f(a.x & 0xffffu) + bf2f(b.x & 0xffffu); v[r][j][1] += bf2f(a.x >> 16) + bf2f(b.x >> 16);
                    v[r][j][2] += bf2f(a.y & 0xffffu) + bf2f(b.y & 0xffffu); v[r][j][3] += bf2f(a.y >> 16) + bf2f(b.y >> 16); }
                if (hb) { u32x2* o = (u32x2*)((bf16*)X.out + (size_t)t * D) + lane;
#pragma unroll
                    for (int j = 0; j < 4; ++j) { u32x2 w; w.x = pk2(v[r][j][0], v[r][j][1]); w.y = pk2(v[r][j][2], v[r][j][3]); o[64 * j] = w; } }
                else { f32x4* o = (f32x4*)(X.out + (size_t)t * D) + lane;
#pragma unroll
                    for (int j = 0; j < 4; ++j) o[64 * j] = v[r][j]; } } }
        }
        if (hb) {
#pragma unroll
            for (int r = 0; r < R; ++r) { const int t = t0 + r * ngw; if (t < T) { float ss = 0.f;
#pragma unroll
                for (int j = 0; j < 4; ++j) ss += (v[r][j][0] * v[r][j][0] + v[r][j][1] * v[r][j][1]) + (v[r][j][2] * v[r][j][2] + v[r][j][3] * v[r][j][3]);
                const float rs = 1.0f / sqrtf(wave_sum(ss) * (1.0f / D) + EPS);
                u32x2* o8 = (u32x2*)(hb + (size_t)t * D) + lane; const f32x4* g4 = (const f32x4*)gain + lane;
                unsigned* q8 = (unsigned*)(hb8 + (size_t)t * D) + lane;
#pragma unroll
                for (int j = 0; j < 4; ++j) { const f32x4 g = g4[64 * j]; const float y0 = v[r][j][0] * rs * g[0], y1 = v[r][j][1] * rs * g[1], y2 = v[r][j][2] * rs * g[2], y3 = v[r][j][3] * rs * g[3];
                    u32x2 w; w.x = pk2(y0, y1); w.y = pk2(y2, y3); o8[64 * j] = w; q8[64 * j] = pk4f8(y0, y1, y2, y3); } } }
        }
    }
}

__device__ __forceinline__ void unpack8(const u32x4 r, float* f) {
    f[0] = bf2f(r.x & 0xffffu); f[1] = bf2f(r.x >> 16); f[2] = bf2f(r.y & 0xffffu); f[3] = bf2f(r.y >> 16);
    f[4] = bf2f(r.z & 0xffffu); f[5] = bf2f(r.z >> 16); f[6] = bf2f(r.w & 0xffffu); f[7] = bf2f(r.w >> 16);
}
__device__ __forceinline__ u32x4 pack8(const float* f) { u32x4 o; o.x = pk2(f[0], f[1]); o.y = pk2(f[2], f[3]); o.z = pk2(f[4], f[5]); o.w = pk2(f[6], f[7]); return o; }
__device__ __forceinline__ float ssq8(const u32x4 r) { float f[8]; unpack8(r, f); float s = 0.f;
#pragma unroll
    for (int j = 0; j < 8; ++j) s += f[j] * f[j];
    return s; }
__device__ __forceinline__ void phase_sgu(const Ctx& X, LAS float* stat  , const int wv) {
    typedef float f32x16 __attribute__((ext_vector_type(16)));
    const int tid = tid_(wv); const int lane = tid & 63, wid = __builtin_amdgcn_readfirstlane(tid >> 6), r32 = lane & 31, hi = lane >> 5;
    const bf16* ug = X.act(A_SGU); const bf16* vt = X.act(A_VT); bf16* ysg = X.act(A_YAS) + 512; const bf16* wsb = X.w(W_S);
    const float* lng = X.inp(10, 512); const float* lnb = X.inp(11, 512); const float* bs = X.inp(13, (size_t)8 * 128);
    LAS float* red = stat + 256;
    for (int un = blockIdx.x; un < T / 128; un += gridDim.x) {
        const bf16* vt_ = vt; const bf16* ug_ = ug; bf16* ysg_ = ysg; const bf16* wsb_ = wsb;
        asm volatile("" : "+s"(vt_), "+s"(ug_), "+s"(ysg_), "+s"(wsb_));
        const int b = un >> 5, ck = un & 31, t0 = un * 128; const bf16* vtile = vt_ + (size_t)b * 512 * 4096 + ck * 128;
        const int g = wid;
        u32x4 vraw[8][2];
        { const int chg = lane >> 4, oct = lane & 15; u32x4 sv[16];
          { const unsigned soff = (unsigned)((chg * 4096 + 8 * oct) * 2);
            const char* sb = (const char*)(vtile + (size_t)(wid * 64) * 4096);
#pragma unroll
            for (int i = 0; i < 16; ++i) sv[i] = *(const u32x4*)(sb + (size_t)i * (4 * 4096 * 2) + soff); }
          float s1[8], s2[8];
#pragma unroll
          for (int j = 0; j < 8; ++j) { s1[j] = 0.f; s2[j] = 0.f; }
#pragma unroll
          for (int i = 0; i < 16; ++i) { float f[8]; unpack8(sv[i], f);
#pragma unroll
              for (int j = 0; j < 8; ++j) { s1[j] += f[j]; s2[j] += f[j] * f[j]; } }
          asm volatile("" ::: "memory");
#pragma unroll
          for (int ks = 0; ks < 8; ++ks)
#pragma unroll
              for (int cb = 0; cb < 2; ++cb) vraw[ks][cb] = *(const u32x4*)((const char*)(vtile + (size_t)(g * 64 + cb * 32) * 4096 + ks * 16) + (unsigned)((r32 * 4096 + 8 * hi) * 2));
#pragma unroll
          for (int j = 0; j < 8; ++j) { s1[j] += __shfl_xor(s1[j], 16); s1[j] += __shfl_xor(s1[j], 32); s2[j] += __shfl_xor(s2[j], 16); s2[j] += __shfl_xor(s2[j], 32); }
          __syncthreads();
          if (chg == 0) {
#pragma unroll
              for (int j = 0; j < 8; ++j) { red[((wid * 128) + 8 * oct + j) * 2] = s1[j]; red[((wid * 128) + 8 * oct + j) * 2 + 1] = s2[j]; } } }
        __syncthreads();
        if (tid < 128) { float s1 = 0.f, s2 = 0.f;
#pragma unroll
            for (int pp = 0; pp < 8; ++pp) { s1 += red[(pp * 128 + tid) * 2]; s2 += red[(pp * 128 + tid) * 2 + 1]; }
            const float mu = s1 * (1.0f / 512.0f), var = fmaxf(s2 * (1.0f / 512.0f) - mu * mu, 0.f);
            stat[2 * tid] = mu; stat[2 * tid + 1] = 1.0f / sqrtf(var + EPS); }
        __syncthreads();
        float gam[2], bet[2];
#pragma unroll
        for (int cb = 0; cb < 2; ++cb) { gam[cb] = lng[g * 64 + cb * 32 + r32]; bet[cb] = lnb[g * 64 + cb * 32 + r32]; }
        bf16x8 bfr[8][2];
#pragma unroll
        for (int ks = 0; ks < 8; ++ks) {
            const int q0 = ks * 16 + 8 * hi;
            float mu[8], rs[8];
#pragma unroll
            for (int j = 0; j < 8; ++j) { mu[j] = stat[2 * (q0 + j)]; rs[j] = stat[2 * (q0 + j) + 1]; }
#pragma unroll
            for (int cb = 0; cb < 2; ++cb) { const u32x4 raw = vraw[ks][cb];
                float f[8] = {bf2f(raw.x & 0xffffu), bf2f(raw.x >> 16), bf2f(raw.y & 0xffffu), bf2f(raw.y >> 16), bf2f(raw.z & 0xffffu), bf2f(raw.z >> 16), bf2f(raw.w & 0xffffu), bf2f(raw.w >> 16)};
#pragma unroll
                for (int j = 0; j < 8; ++j) f[j] = (f[j] - mu[j]) * rs[j] * gam[cb] + bet[cb];
                u32x4 w; w.x = pk2(f[0], f[1]); w.y = pk2(f[2], f[3]); w.z = pk2(f[4], f[5]); w.w = pk2(f[6], f[7]);
                bfr[ks][cb] = *reinterpret_cast<bf16x8*>(&w); }
        }
        const unsigned woff = (unsigned)((r32 * 128 + 8 * hi) * 2), uoff = (unsigned)((r32 * 512 + 4 * hi) * 2), yoff = (unsigned)((r32 * 1024 + 4 * hi) * 2);
#pragma unroll
        for (int pb = 0; pb < 4; ++pb) {
            bf16x8 wf[8]; u32x2 uu[2][4];
            const char* wb = (const char*)(wsb_ + ((size_t)g * 128 + pb * 32) * 128); const char* ub = (const char*)(ug_ + (size_t)(t0 + pb * 32) * 512 + g * 64);
#pragma unroll
            for (int ks = 0; ks < 8; ++ks) wf[ks] = *(const bf16x8*)(wb + ks * 32 + woff);
            const float bias = bs[g * 128 + pb * 32 + r32];
#pragma unroll
            for (int cb = 0; cb < 2; ++cb)
#pragma unroll
                for (int k = 0; k < 4; ++k) uu[cb][k] = *(const u32x2*)(ub + (cb * 32 + 8 * k) * 2 + uoff);
            f32x16 acc[2];
#pragma unroll
            for (int cb = 0; cb < 2; ++cb) acc[cb] = f32x16{};
#pragma unroll
            for (int ks = 0; ks < 8; ++ks)
#pragma unroll
                for (int cb = 0; cb < 2; ++cb) acc[cb] = __builtin_amdgcn_mfma_f32_32x32x16_bf16(bfr[ks][cb], wf[ks], acc[cb], 0, 0, 0);
            char* yb = (char*)(ysg_ + (size_t)(t0 + pb * 32) * 1024 + g * 64);
#pragma unroll
            for (int cb = 0; cb < 2; ++cb)
#pragma unroll
                for (int k = 0; k < 4; ++k) { const u32x2 uv = uu[cb][k]; u32x2 o;
                    o.x = pk2(bf2f(uv.x & 0xffffu) * (acc[cb][4 * k] + bias), bf2f(uv.x >> 16) * (acc[cb][4 * k + 1] + bias));
                    o.y = pk2(bf2f(uv.y & 0xffffu) * (acc[cb][4 * k + 2] + bias), bf2f(uv.y >> 16) * (acc[cb][4 * k + 3] + bias));
                    *(u32x2*)(yb + (cb * 32 + 8 * k) * 2 + yoff) = o; }
            asm volatile("" ::: "memory");
        }
    }
    { const int tid = tid_(wv), lane = tid & 63;
      const bf16* zt = X.act(A_ZT); bf16* zri = X.act(A_ZRI); const int gw0 = (blockIdx.x * blockDim.x + tid) >> 6, ngw0 = (gridDim.x * blockDim.x) >> 6;
      for (int it = gw0; it < NB * 512; it += ngw0) { const bf16* zr = zt + (size_t)it * 4096 + lane * 64; float a = 0.f;
#pragma unroll
          for (int k = 0; k < 8; ++k) { float f[8]; unpack8(*(const u32x4*)(zr + 8 * k), f); a += (f[0] - f[1]) + (f[2] - f[3]) + (f[4] - f[5]) + (f[6] - f[7]); }
          a = wave_sum(a);
          if (lane == 0) { const int b = it >> 9, ch = it & 511; bf16* o = zri + ((size_t)b * 4096 + 2048) * 1024 + ch; o[0] = (bf16)f2bf(a * 0.015625f); o[512] = 0; } } }
    { const int tid3 = tid_(wv); const int gt = blockIdx.x * blockDim.x + tid3, gs = gridDim.x * blockDim.x; const bf16* zt = X.act(A_ZT); bf16* zf = X.act(A_ZF);
      for (int it = gt; it < NB * 512 * (KF / 8); it += gs) {
          const int g8 = it % (KF / 8), bc = it / (KF / 8), b = bc >> 9, ch = bc & 511, m0 = g8 * 8; const bf16* zr = zt + (size_t)bc * 4096;
          float ee[8], eo[8], oe[8], oo[8];
#pragma unroll
          for (int j = 0; j < 8; ++j) { ee[j] = 0.f; eo[j] = 0.f; oe[j] = 0.f; oo[j] = 0.f; }
          if (m0 < 1024) { float a[8], d[8], ra[8], rb[8]; unpack8(*(const u32x4*)(zr + m0), a); unpack8(*(const u32x4*)(zr + 2048 + m0), d);
              unpack8(*(const u32x4*)(zr + 4096 - m0 - 8), ra); unpack8(*(const u32x4*)(zr + 2048 - m0 - 8), rb);
              if (m0 == 0) { ee[0] = a[0] + d[0]; eo[0] = a[0] - d[0]; }
              else { const float pa = bf2f(zr[4096 - m0]), pb = bf2f(zr[2048 - m0]); const float e1 = a[0] + pa, e2 = pb + d[0], o1 = a[0] - pa, o2 = pb - d[0];
                  ee[0] = e1 + e2; eo[0] = e1 - e2; oe[0] = o1 - o2; oo[0] = o1 + o2; }
#pragma unroll
              for (int j = 1; j < 8; ++j) { const float e1 = a[j] + ra[8 - j], e2 = rb[8 - j] + d[j], o1 = a[j] - ra[8 - j], o2 = rb[8 - j] - d[j];
                  ee[j] = e1 + e2; eo[j] = e1 - e2; oe[j] = o1 - o2; oo[j] = o1 + o2; } }
          else if (m0 == 1024) { const float a0 = bf2f(zr[1024]), d0 = bf2f(zr[3072]); ee[0] = a0 + d0; oo[0] = a0 - d0; }
          bf16* o = zf + ((size_t)(b * 4) * 512 + ch) * KF + m0;
          *(u32x4*)(o) = pack8(ee); *(u32x4*)(o + (size_t)512 * KF) = pack8(eo); *(u32x4*)(o + (size_t)2 * 512 * KF) = pack8(oe); *(u32x4*)(o + (size_t)3 * 512 * KF) = pack8(oo);
      } }
    const int tid2 = tid_(wv), lane2 = tid2 & 63;
    const int gw = (blockIdx.x * blockDim.x + tid2) >> 6, ngw = (gridDim.x * blockDim.x) >> 6;
    const bf16* lat = X.act(A_LAT); float* rsq = (float*)X.misc(M_RSQ); float* rskv = (float*)X.misc(M_RSKV);
    const int li = lane2 & 15, tg = lane2 >> 4;
    for (int t4 = gw; t4 < T / 4; t4 += ngw) {
        const int t = t4 * 4 + tg; const bf16* r = lat + (size_t)t * 768 + li * 8;
        u32x4 c[5];
#pragma unroll
        for (int k = 0; k < 5; ++k) c[k] = *(const u32x4*)(r + 128 * k);
        float sq = ssq8(c[0]) + ssq8(c[1]) + ssq8(c[2]), sk = ssq8(c[3]) + ssq8(c[4]);
#pragma unroll
        for (int o = 1; o < 16; o <<= 1) { sq += __shfl_xor(sq, o); sk += __shfl_xor(sk, o); }
        if (li == 0) { rsq[t] = 1.0f / sqrtf(sq * (1.0f / 384.0f) + EPS); rskv[t] = 1.0f / sqrtf(sk * (1.0f / 256.0f) + EPS); }
    }
}

__device__ __forceinline__ void rope_store(const bf16* src32, float mul, const float* gain, const float* cs, const float* sn, float post, bf16* dst) {
    float a[16], b[16];
    unpack8(*(const u32x4*)(src32), a); unpack8(*(const u32x4*)(src32 + 8), a + 8); unpack8(*(const u32x4*)(src32 + 16), b); unpack8(*(const u32x4*)(src32 + 24), b + 8);
#pragma unroll
    for (int i = 0; i < 16; ++i) { const float x1 = a[i] * mul * gain[64 + i], x2 = b[i] * mul * gain[80 + i]; a[i] = (x1 * cs[i] - x2 * sn[i]) * post; b[i] = (x1 * sn[i] + x2 * cs[i]) * post; }
    *(u32x4*)(dst + 64) = pack8(a); *(u32x4*)(dst + 72) = pack8(a + 8); *(u32x4*)(dst + 80) = pack8(b); *(u32x4*)(dst + 88) = pack8(b + 8);
}
__device__ __forceinline__ void phase_prep(const Ctx& X, const int wv) {
    const int tid = tid_(wv); const int lane = tid & 63, sub = lane & 7, hd = lane >> 3, q4 = sub & 3, ii = 8 * (q4 & 1);
    const int gw = (blockIdx.x * blockDim.x + tid) >> 6, ngw = (gridDim.x * blockDim.x) >> 6;
    const bf16* kv = X.act(A_KV); bf16* kb = X.act(A_KB); const bf16* lat = X.act(A_LAT);
    const float* kn = X.inp(9, QKH); const float* cst = (const float*)X.misc(M_CS); const float* snt = (const float*)X.misc(M_SN);
    float gn[8], g1[8], g2[8];
#pragma unroll
    for (int j = 0; j < 8; ++j) { gn[j] = kn[8 * sub + j]; g1[j] = kn[64 + ii + j]; g2[j] = kn[80 + ii + j]; }
    constexpr int U = 4;
    for (int t0 = gw; t0 < T; t0 += U * ngw) {
        u32x4 nk[U], ro[U], rq[U]; f32x4 c0[U], c1[U], s0[U], s1[U];
#pragma unroll
        for (int u = 0; u < U; ++u) { const int t = t0 + u * ngw; nk[u] = (u32x4){0u, 0u, 0u, 0u}; ro[u] = nk[u]; rq[u] = nk[u]; c0[u] = (f32x4){0.f, 0.f, 0.f, 0.f}; c1[u] = c0[u]; s0[u] = c0[u]; s1[u] = c0[u];
            if (t < T) { nk[u] = *(const u32x4*)(kv + (size_t)t * 1024 + hd * 128 + 8 * sub);
                if (sub < 4) { const bf16* rp = lat + (size_t)t * 768 + 640; ro[u] = *(const u32x4*)(rp + 8 * q4); rq[u] = *(const u32x4*)(rp + 8 * (q4 ^ 2));
                    const f32x4* cp = (const f32x4*)(cst + (size_t)t * 16 + ii); const f32x4* sp = (const f32x4*)(snt + (size_t)t * 16 + ii); c0[u] = cp[0]; c1[u] = cp[1]; s0[u] = sp[0]; s1[u] = sp[1]; } } }
#pragma unroll
        for (int u = 0; u < U; ++u) { const int t = t0 + u * ngw;
            float ss = ssq8(nk[u]) + (sub < 4 ? ssq8(ro[u]) : 0.f);
            ss += __shfl_xor(ss, 1); ss += __shfl_xor(ss, 2); ss += __shfl_xor(ss, 4);
            const float r2 = 1.0f / sqrtf(ss * (1.0f / 96.0f) + EPS);
            if (t < T) { bf16* ko = kb + (size_t)t * 768 + hd * 96;
                float f[8]; unpack8(nk[u], f);
#pragma unroll
                for (int j = 0; j < 8; ++j) f[j] = f[j] * r2 * gn[j];
                *(u32x4*)(ko + 8 * sub) = pack8(f);
                if (sub < 4) { float a[8], b[8]; unpack8(q4 < 2 ? ro[u] : rq[u], a); unpack8(q4 < 2 ? rq[u] : ro[u], b);
#pragma unroll
                    for (int j = 0; j < 8; ++j) { const float cc = j < 4 ? c0[u][j & 3] : c1[u][j & 3], sn_ = j < 4 ? s0[u][j & 3] : s1[u][j & 3]; const float x1 = a[j] * r2 * g1[j], x2 = b[j] * r2 * g2[j];
                        f[j] = q4 < 2 ? x1 * cc - x2 * sn_ : x1 * sn_ + x2 * cc; }
                    *(u32x4*)(ko + 64 + 8 * q4) = pack8(f); } } }
    }
}

__device__ __forceinline__ void phase_attn_naive(const Ctx& X, const int wv) {
    const int tid = tid_(wv); const int lane = tid & 63, fr = lane & 15, fq = lane >> 4;
    const int gw = (blockIdx.x * blockDim.x + tid) >> 6, ngw = (gridDim.x * blockDim.x) >> 6;
    const bf16* qb = X.act(A_Q); const bf16* kb = X.act(A_KB); const bf16* kv = X.act(A_KV); bf16* ya = X.act(A_YAS);
    for (int un = gw; un < NB * NH * (SEQ / 16); un += ngw) {
        const int qt = un & 255, h = (un >> 8) & 7, b = un >> 11; const int tq = b * SEQ + qt * 16;
        bf16x8 qf[3];
#pragma unroll
        for (int s = 0; s < 3; ++s) qf[s] = *(const bf16x8*)(qb + (size_t)(tq + fr) * 768 + h * 96 + s * 32 + 8 * fq);
        f32x4 o[4]; for (int d = 0; d < 4; ++d) o[d] = (f32x4){0.f, 0.f, 0.f, 0.f};
        float m = -1e30f, l = 0.f;
        for (int k0 = 0; k0 < SEQ; k0 += 32) {
            const int tk = b * SEQ + k0;
            f32x4 s0 = (f32x4){0.f, 0.f, 0.f, 0.f}, s1 = s0;
#pragma unroll
            for (int s = 0; s < 3; ++s) {
                const bf16x8 k0f = *(const bf16x8*)(kb + (size_t)(tk + fr) * 768 + h * 96 + s * 32 + 8 * fq);
                const bf16x8 k1f = *(const bf16x8*)(kb + (size_t)(tk + 16 + fr) * 768 + h * 96 + s * 32 + 8 * fq);
                s0 = __builtin_amdgcn_mfma_f32_16x16x32_bf16(k0f, qf[s], s0, 0, 0, 0);
                s1 = __builtin_amdgcn_mfma_f32_16x16x32_bf16(k1f, qf[s], s1, 0, 0, 0);
            }
            float mx = fmaxf(fmaxf(fmaxf(s0[0], s0[1]), fmaxf(s0[2], s0[3])), fmaxf(fmaxf(s1[0], s1[1]), fmaxf(s1[2], s1[3])));
            mx = fmaxf(mx, __shfl_xor(mx, 16)); mx = fmaxf(mx, __shfl_xor(mx, 32));
            const float mn = fmaxf(m, mx), al = exp2f(m - mn); m = mn;
            float p[8]; float ps = 0.f;
#pragma unroll
            for (int j = 0; j < 4; ++j) { p[j] = exp2f(s0[j] - mn); p[4 + j] = exp2f(s1[j] - mn); ps += p[j] + p[4 + j]; }
            l = l * al + ps;
            bf16x8 pf;
#pragma unroll
            for (int j = 0; j < 8; ++j) pf[j] = (short)f2bf(p[j]);
#pragma unroll
            for (int d = 0; d < 4; ++d) {
                bf16x8 vf;
#pragma unroll
                for (int j = 0; j < 8; ++j) { const int key = tk + (j < 4 ? 4 * fq + j : 16 + 4 * fq + (j - 4)); vf[j] = (short)kv[(size_t)key * 1024 + h * 128 + 64 + d * 16 + fr]; }
                o[d] = o[d] * al;
                o[d] = __builtin_amdgcn_mfma_f32_16x16x32_bf16(vf, pf, o[d], 0, 0, 0);
            }
        }
        l += __shfl_xor(l, 16); l += __shfl_xor(l, 32);
        const float il = 1.0f / l;
#pragma unroll
        for (int d = 0; d < 4; ++d) { u32x2 w; w.x = pk2(o[d][0] * il, o[d][1] * il); w.y = pk2(o[d][2] * il, o[d][3] * il);
            *(u32x2*)(ya + (size_t)(tq + fr) * 1024 + h * 64 + d * 16 + 4 * fq) = w; }
    }
}

namespace at {
typedef float f32x16 __attribute__((ext_vector_type(16)));
typedef short s16x4 __attribute__((ext_vector_type(4)));
constexpr int SHM_V = 64 * 64 * 2, SHM_K = 64 * 256, LDS_NEED = 3 * SHM_V + 3 * SHM_K + 8 * 64 * 4;
constexpr float THR2 = 11.5f;
#define KSWZ(row, colB) ((row) * 256 + ((colB) ^ (((row) & 15) << 4)))
#define SBAR() __builtin_amdgcn_sched_barrier(0)
__device__ __forceinline__ int crow(int r, int hi) { return (r & 3) + 8 * (r >> 2) + 4 * hi; }
__device__ __forceinline__ unsigned cvtpk(float lo, float hi) { unsigned r; asm volatile("v_cvt_pk_bf16_f32 %0, %1, %2" : "=v"(r) : "v"(lo), "v"(hi)); return r; }
__device__ __forceinline__ void decide(f32x16& p0, f32x16& p1, float& m_reg, f32x16& negm, float& alpha) {
    float pmax = p0[0];
#pragma unroll
    for (int r = 1; r < 16; ++r) pmax = fmaxf(pmax, p0[r]);
#pragma unroll
    for (int r = 0; r < 16; ++r) pmax = fmaxf(pmax, p1[r]);
    { auto rr = __builtin_amdgcn_permlane32_swap(__float_as_uint(pmax), __float_as_uint(pmax), false, false); pmax = fmaxf(__uint_as_float(rr[0]), __uint_as_float(rr[1])); }
    alpha = 1.f;
    if (__builtin_expect(!__all(pmax <= THR2), 0)) {
        const float dl = fmaxf(pmax, 0.f); m_reg += dl; alpha = __builtin_amdgcn_exp2f(-dl);
#pragma unroll
        for (int r = 0; r < 16; ++r) { p0[r] -= dl; p1[r] -= dl; negm[r] = -m_reg; }
    }
}
__device__ __forceinline__ void exp8(f32x16& p, int base) {
#pragma unroll
    for (int r = 0; r < 8; ++r) p[base + r] = __builtin_amdgcn_exp2f(p[base + r]);
}
__device__ __forceinline__ void finishSM(f32x16& p0, f32x16& p1, bf16x8& pa0, bf16x8& pa1, bf16x8& pa2, bf16x8& pa3) {
#pragma unroll
    for (int r = 0; r < 16; ++r) p1[r] = __builtin_amdgcn_exp2f(p1[r]);
#define PK4(P, BASE, OUT) do { u32x4 w = {cvtpk(P[BASE + 0], P[BASE + 1]), cvtpk(P[BASE + 2], P[BASE + 3]), cvtpk(P[BASE + 4], P[BASE + 5]), cvtpk(P[BASE + 6], P[BASE + 7])}; OUT = *reinterpret_cast<bf16x8*>(&w); } while (0)
    PK4(p0, 0, pa0); PK4(p0, 8, pa1); PK4(p1, 0, pa2); PK4(p1, 8, pa3);
#undef PK4
}
__device__ __forceinline__ void qkt(f32x16& p0, f32x16& p1, const char* Ks, const bf16x8* qr, const f32x16& negm, int r32, int hi) {
#pragma unroll
    for (int d0 = 0; d0 < 6; ++d0) { const int cb = (d0 * 16 + hi * 8) * 2;
        const bf16x8 b0 = *reinterpret_cast<const bf16x8*>(Ks + KSWZ(r32, cb));
        const bf16x8 b1 = *reinterpret_cast<const bf16x8*>(Ks + KSWZ(32 + r32, cb));
        if (d0 == 0) { p0 = __builtin_amdgcn_mfma_f32_32x32x16_bf16(b0, qr[0], negm, 0, 0, 0); p1 = __builtin_amdgcn_mfma_f32_32x32x16_bf16(b1, qr[0], negm, 0, 0, 0); }
        else { p0 = __builtin_amdgcn_mfma_f32_32x32x16_bf16(b0, qr[d0], p0, 0, 0, 0); p1 = __builtin_amdgcn_mfma_f32_32x32x16_bf16(b1, qr[d0], p1, 0, 0, 0); } }
}
__device__ __forceinline__ int v_st(int k, int c) { const int kk = (k & ~0xC) | ((k & 4) << 1) | ((k & 8) >> 1); return ((kk >> 3) * 2 + (c >> 5)) * 512 + ((kk & 7) * 32 + (c & 31)) * 2; }
__device__ __forceinline__ int v_rd_base(int lane) { return ((lane & 3) << 3) | (((lane >> 2) & 3) << 6) | (((lane >> 4) & 1) << 5) | (((lane >> 5) & 1) << 8); }
constexpr int v_rd_off(int d0, int ks, int half) { return d0 * 512 + ks * 2048 + half * 1024; }
template <int OFF> __device__ __forceinline__ s16x4 tr_read(int vb) { s16x4 r; asm volatile("ds_read_b64_tr_b16 %0, %1 offset:%2" : "=&v"(r) : "v"(vb), "i"(OFF) : "memory"); return r; }
template <int D0> __device__ __forceinline__ void pv_one(f32x16& od, int vb, bf16x8 pa0, bf16x8 pa1, bf16x8 pa2, bf16x8 pa3) {
    const s16x4 l0 = tr_read<v_rd_off(D0, 0, 0)>(vb), h0 = tr_read<v_rd_off(D0, 0, 1)>(vb), l1 = tr_read<v_rd_off(D0, 1, 0)>(vb), h1 = tr_read<v_rd_off(D0, 1, 1)>(vb);
    const s16x4 l2 = tr_read<v_rd_off(D0, 2, 0)>(vb), h2 = tr_read<v_rd_off(D0, 2, 1)>(vb), l3 = tr_read<v_rd_off(D0, 3, 0)>(vb), h3 = tr_read<v_rd_off(D0, 3, 1)>(vb);
    asm volatile("s_waitcnt lgkmcnt(0)" ::: "memory"); SBAR();
#define PK(L, H) (bf16x8){L[0], L[1], L[2], L[3], H[0], H[1], H[2], H[3]}
    od = __builtin_amdgcn_mfma_f32_32x32x16_bf16(pa0, PK(l0, h0), od, 0, 0, 0);
    od = __builtin_amdgcn_mfma_f32_32x32x16_bf16(pa1, PK(l1, h1), od, 0, 0, 0);
    od = __builtin_amdgcn_mfma_f32_32x32x16_bf16(pa2, PK(l2, h2), od, 0, 0, 0);
    od = __builtin_amdgcn_mfma_f32_32x32x16_bf16(pa3, PK(l3, h3), od, 0, 0, 0);
#undef PK
}
__device__ __forceinline__ void psum(f32x16& osum, bf16x8 ones, bf16x8 pa0, bf16x8 pa1, bf16x8 pa2, bf16x8 pa3) {
    osum = __builtin_amdgcn_mfma_f32_32x32x16_bf16(pa0, ones, osum, 0, 0, 0); osum = __builtin_amdgcn_mfma_f32_32x32x16_bf16(pa1, ones, osum, 0, 0, 0);
    osum = __builtin_amdgcn_mfma_f32_32x32x16_bf16(pa2, ones, osum, 0, 0, 0); osum = __builtin_amdgcn_mfma_f32_32x32x16_bf16(pa3, ones, osum, 0, 0, 0);
}
__device__ __forceinline__ void pv_d0(f32x16* o, f32x16& osum, bf16x8 ones, int vb, bf16x8 pa0, bf16x8 pa1, bf16x8 pa2, bf16x8 pa3) { psum(osum, ones, pa0, pa1, pa2, pa3); pv_one<0>(o[0], vb, pa0, pa1, pa2, pa3); pv_one<1>(o[1], vb, pa0, pa1, pa2, pa3); }
__device__ __forceinline__ void pv_exp(f32x16* o, f32x16& osum, bf16x8 ones, int vb, bf16x8 pa0, bf16x8 pa1, bf16x8 pa2, bf16x8 pa3, f32x16& pn) { psum(osum, ones, pa0, pa1, pa2, pa3); pv_one<0>(o[0], vb, pa0, pa1, pa2, pa3); exp8(pn, 0); pv_one<1>(o[1], vb, pa0, pa1, pa2, pa3); exp8(pn, 8); }

__device__ __forceinline__ void unit(const bf16* __restrict__ Qb, const bf16* __restrict__ Kh, const bf16* __restrict__ Vh, bf16* __restrict__ Ob, const float* __restrict__ qn, const float* __restrict__ cst, const float* __restrict__ snt, int tok0, float gmk, char* lds, LAS unsigned char* L3, int tid) {
    const int wid = __builtin_amdgcn_readfirstlane(tid >> 6), lane = tid & 63, r32 = lane & 31, hi = lane >> 5;
    const bf16* Qw = Qb + (unsigned)((wid * 32 + r32) * 768 + hi * 8); bf16* Ow = Ob + (unsigned)(wid * 32 * 1024);
    char* V_lds = lds; char* K_lds = lds + 3 * SHM_V;
    float* ws = (float*)(lds + 3 * SHM_V + 3 * SHM_K) + wid * 64; float* li_l = ws; float* al_l = ws + 32;
    bf16x8 qr[6];
    f32x16 negm = f32x16{}; asm volatile("" : "+v"(negm));
    {
        float qf[6][8]; float ss = 0.f;
#pragma unroll
        for (int d0 = 0; d0 < 6; ++d0) { unpack8(*reinterpret_cast<const u32x4*>(Qw + d0 * 16), qf[d0]);
#pragma unroll
            for (int j = 0; j < 8; ++j) ss += qf[d0][j] * qf[d0][j]; }
        { auto rr = __builtin_amdgcn_permlane32_swap(__float_as_uint(ss), __float_as_uint(ss), false, false); ss = __uint_as_float(rr[0]) + __uint_as_float(rr[1]); }
        const float mul = QSCALE / sqrtf(ss * (1.0f / 96.0f) + EPS);
#pragma unroll
        for (int d0 = 0; d0 < 6; ++d0) { const f32x4 g0 = *(const f32x4*)(qn + d0 * 16 + hi * 8), g1 = *(const f32x4*)(qn + d0 * 16 + hi * 8 + 4);
#pragma unroll
            for (int j = 0; j < 4; ++j) { qf[d0][j] *= mul * g0[j]; qf[d0][4 + j] *= mul * g1[j]; } }
        { const float* cp = cst + (size_t)(tok0 + wid * 32 + r32) * 16 + hi * 8; const float* sp = snt + (size_t)(tok0 + wid * 32 + r32) * 16 + hi * 8;
          const f32x4 c0 = *(const f32x4*)cp, c1 = *(const f32x4*)(cp + 4), s0_ = *(const f32x4*)sp, s1_ = *(const f32x4*)(sp + 4);
#pragma unroll
          for (int j = 0; j < 8; ++j) { const float c = j < 4 ? c0[j & 3] : c1[j & 3], sn_ = j < 4 ? s0_[j & 3] : s1_[j & 3]; const float a = qf[4][j], b = qf[5][j]; qf[4][j] = a * c - b * sn_; qf[5][j] = a * sn_ + b * c; } }
        float q2 = 0.f;
#pragma unroll
        for (int d0 = 0; d0 < 6; ++d0) { const u32x4 w = pack8(qf[d0]); qr[d0] = __builtin_bit_cast(bf16x8, w);
            float qq[8]; unpack8(w, qq);
#pragma unroll
            for (int j = 0; j < 8; ++j) q2 += qq[j] * qq[j]; }
        { auto rr = __builtin_amdgcn_permlane32_swap(__float_as_uint(q2), __float_as_uint(q2), false, false); q2 = __uint_as_float(rr[0]) + __uint_as_float(rr[1]); }
        const float mrow = fminf(sqrtf(q2) * gmk * 1.002f + 0.05f, 100.0f);
#pragma unroll
        for (int r = 0; r < 16; ++r) negm[r] = -mrow;
        asm volatile("" : "+v"(negm));
    }
    f32x16 o[2] = {}, osum = {}; const short one_ = (r32 == 0) ? (short)0x3F80 : (short)0; const bf16x8 ones = (bf16x8){one_, one_, one_, one_, one_, one_, one_, one_};
    const int krow0 = wid * 8 + (lane >> 4), kslot = lane & 15;
    int kc0 = kslot ^ (krow0 & 15), kc1 = kslot ^ ((krow0 + 4) & 15); kc0 = kc0 < 12 ? kc0 : kc0 - 12; kc1 = kc1 < 12 ? kc1 : kc1 - 12;
    const unsigned koff0 = (unsigned)(krow0 * 768 + kc0 * 8) * 2u, koff1 = (unsigned)((krow0 + 4) * 768 + kc1 * 8) * 2u;
    const int vkey = wid * 8 + ((lane & 31) >> 2);
    const unsigned voff = (unsigned)(vkey * 1024 + (lane >> 5) * 32 + (lane & 3) * 8) * 2u;
    const int vb0 = (int)(uintptr_t)V_lds + v_rd_base(lane);
#define DMA(slot, t) do { const char* kt = (const char*)Kh + (size_t)(t) * (64 * 768 * 2); const char* vt = (const char*)Vh + (size_t)(t) * (64 * 1024 * 2); \
    __builtin_amdgcn_global_load_lds((const unsigned*)(kt + koff0), (LAS unsigned*)(L3 + 3 * SHM_V + (slot) * SHM_K + wid * 2048), 16, 0, 0); \
    __builtin_amdgcn_global_load_lds((const unsigned*)(kt + koff1), (LAS unsigned*)(L3 + 3 * SHM_V + (slot) * SHM_K + wid * 2048 + 1024), 16, 0, 0); \
    __builtin_amdgcn_global_load_lds((const unsigned*)(vt + voff), (LAS unsigned*)(L3 + (slot) * SHM_V + wid * 1024), 16, 0, 0); } while (0)
#define DMA_WAIT_BAR() do { asm volatile("s_waitcnt vmcnt(0)" ::: "memory"); __syncthreads(); } while (0)
#define RESC(a) do { if (__any((a) < 1.f)) { if (hi == 0) al_l[r32] = (a); asm volatile("s_waitcnt lgkmcnt(0)" ::: "memory"); \
    _Pragma("unroll") for (int d = 0; d < 2; ++d) _Pragma("unroll") for (int r = 0; r < 16; ++r) o[d][r] *= al_l[crow(r, hi)]; } } while (0)
#define NXT(x) ((x) == 2 ? 0 : (x) + 1)
    f32x16 pA0, pA1, pB0, pB1; bf16x8 pa0, pa1, pa2, pa3; constexpr int NT = SEQ / 64;
    DMA(0, 0); DMA(1, 1); DMA_WAIT_BAR();
    qkt(pA0, pA1, K_lds, qr, negm, r32, hi); exp8(pA0, 0); exp8(pA0, 8);
    int s0 = 0;
    for (int t = 0; t + 2 < NT; t += 2) {
        const int s1 = NXT(s0), s2 = NXT(s1);
        DMA(s2, t + 2);
        SBAR(); qkt(pB0, pB1, K_lds + s1 * SHM_K, qr, negm, r32, hi);
        finishSM(pA0, pA1, pa0, pa1, pa2, pa3); SBAR();
        pv_exp(o, osum, ones, vb0 + s0 * SHM_V, pa0, pa1, pa2, pa3, pB0);
        DMA_WAIT_BAR();
        DMA(s0, t + 3);
        SBAR(); qkt(pA0, pA1, K_lds + s2 * SHM_K, qr, negm, r32, hi);
        finishSM(pB0, pB1, pa0, pa1, pa2, pa3); SBAR();
        pv_exp(o, osum, ones, vb0 + s1 * SHM_V, pa0, pa1, pa2, pa3, pA0);
        DMA_WAIT_BAR();
        s0 = s2;
    }
    {
        const int s1 = NXT(s0);
        SBAR(); qkt(pB0, pB1, K_lds + s1 * SHM_K, qr, negm, r32, hi);
        finishSM(pA0, pA1, pa0, pa1, pa2, pa3); SBAR();
        pv_exp(o, osum, ones, vb0 + s0 * SHM_V, pa0, pa1, pa2, pa3, pB0);
        finishSM(pB0, pB1, pa0, pa1, pa2, pa3); SBAR();
        pv_d0(o, osum, ones, vb0 + s1 * SHM_V, pa0, pa1, pa2, pa3);
    }
#undef NXT
#undef DMA
#undef DMA_WAIT_BAR
    if (r32 == 0) {
#pragma unroll
        for (int r = 0; r < 16; ++r) li_l[crow(r, hi)] = osum[r]; }
    asm volatile("s_waitcnt lgkmcnt(0)" ::: "memory");
    float rli[16];
#pragma unroll
    for (int r = 0; r < 16; ++r) rli[r] = __builtin_amdgcn_rcpf(li_l[crow(r, hi)]);
#pragma unroll
    for (int r = 0; r < 16; ++r) { const int orow = crow(r, hi);
#pragma unroll
        for (int d0 = 0; d0 < 2; ++d0) Ow[(long)orow * 1024 + d0 * 32 + r32] = (bf16)f2bf(o[d0][r] * rli[r]); }
    __syncthreads();
#undef RESC
}
#undef KSWZ
#undef SBAR
}
__device__ __forceinline__ void phase_attn_fast(const Ctx& X, char* lds, LAS unsigned char* L3, const int wv) {
    const int tid = tid_(wv);
    const bf16* qb = X.act(A_Q); const bf16* kb = X.act(A_KB); const bf16* kv = X.act(A_KV); bf16* ya = X.act(A_YAS);
    const int G = gridDim.x, c = blockIdx.x; const int vcu = (G % 8 == 0) ? (c % 8) * (G / 8) + c / 8 : c;
    const float gmk = ((const float*)X.misc(M_GMK))[X.l];
    for (int un = vcu; un < NB * NH * (SEQ / 256); un += G) {
        const int qblk = un & 15, h = (un >> 4) & 7, b = un >> 7; const size_t t0 = (size_t)b * SEQ;
        at::unit(qb + (t0 + qblk * 256) * 768 + h * 96, kb + t0 * 768 + h * 96, kv + t0 * 1024 + h * 128 + 64, ya + (t0 + qblk * 256) * 1024 + h * 64,
                 X.inp(8, QKH), (const float*)X.misc(M_CS), (const float*)X.misc(M_SN), (int)t0 + qblk * 256, gmk, lds, L3, tid_(wv));
    }
}

__device__ __forceinline__ void phase_select(const Ctx& X, LAS unsigned* lc  , const int wv) {
    const int tid = tid_(wv);
    const float* lg = (const float*)X.act(A_LOG); const float* bg = X.inp(20, NG); const float* br = X.inp(22, NE);
    int* sele = (int*)X.misc(M_SELE); float* selw = (float*)X.misc(M_SELW); int* selp = (int*)X.misc(M_SELP);
    unsigned* cnt = X.ctl() + CW_CNT + 64 * X.l;
    const float* ssp = (const float*)X.misc(M_SSP); float* rs2 = (float*)X.misc(M_RS2);
    const int G = gridDim.x, per = (T + G - 1) / G;
    for (int i0 = 0; i0 < per; i0 += 512) {
        __syncthreads();
        if (tid < 32) lc[tid] = 0u;
        __syncthreads();
        const int i = i0 + tid, t = blockIdx.x * per + i; const bool on = (i < per) && (t < T);
        int E0 = 0, E1 = 0; unsigned p0 = 0u, p1 = 0u; float w0 = 0.f, w1 = 0.f;
        if (on) {
            const float* r = lg + (size_t)t * 64;
            float ssq = 0.f;
            { const f32x4* sp = (const f32x4*)(ssp + (size_t)t * 16); const f32x4 a = sp[0], b = sp[1], c4 = sp[2], d = sp[3];
              ssq = ((a[0] + a[1]) + (a[2] + a[3])) + ((b[0] + b[1]) + (b[2] + b[3])) + ((c4[0] + c4[1]) + (c4[2] + c4[3])) + ((d[0] + d[1]) + (d[2] + d[3])); }
            const float rsn = 1.0f / sqrtf(ssq * (1.0f / D) + EPS); rs2[t] = rsn;
            float gl[4]; int gs = 0;
#pragma unroll
            for (int q = 0; q < 4; ++q) gl[q] = (r[q] + r[(size_t)T * 64 + q]) * rsn + bg[q];
#pragma unroll
            for (int q = 1; q < 4; ++q) if (gl[q] > gl[gs]) gs = q;
            float den = 0.f;
#pragma unroll
            for (int q = 0; q < 4; ++q) den += expf(gl[q] - gl[gs]);
            const float gw = 1.0f / den;
            float el[8];
#pragma unroll
            for (int q = 0; q < 8; ++q) el[q] = (r[4 + gs * 8 + q] + r[(size_t)T * 64 + 4 + gs * 8 + q]) * rsn + br[gs * 8 + q];
            int q0 = 0;
#pragma unroll
            for (int q = 1; q < 8; ++q) if (el[q] > el[q0]) q0 = q;
            int q1 = (q0 == 0) ? 1 : 0;
#pragma unroll
            for (int q = 0; q < 8; ++q) if (q != q0 && el[q] > el[q1]) q1 = q;
            const float e1 = expf(el[q1] - el[q0]); w0 = gw / (1.0f + e1); w1 = gw * e1 / (1.0f + e1);
            E0 = gs * 8 + q0; E1 = gs * 8 + q1;
            p0 = __hip_atomic_fetch_add(&lc[E0], 1u, __ATOMIC_RELAXED, __HIP_MEMORY_SCOPE_WORKGROUP); p1 = __hip_atomic_fetch_add(&lc[E1], 1u, __ATOMIC_RELAXED, __HIP_MEMORY_SCOPE_WORKGROUP);
        }
        __syncthreads();
        if (tid < 32) { const unsigned n = lc[tid]; lc[32 + tid] = n ? atomicAdd(&cnt[tid], n) : 0u; }
        __syncthreads();
        if (on) { sele[t] = E0 | (E1 << 8); selw[2 * t] = w0; selw[2 * t + 1] = w1; selp[2 * t] = (int)(lc[32 + E0] + p0); selp[2 * t + 1] = (int)(lc[32 + E1] + p1); }
    }
}
__device__ __forceinline__ void moe_table(const Ctx& X, LAS int* tb, const int wv) {
    __syncthreads();
    if (tid_(wv) == 0) { const unsigned* cnt = X.ctl() + CW_CNT + 64 * X.l; int a = 0;
#pragma nounroll
        for (int e = 0; e < 32; ++e) { tb[e] = a; const int n = (int)((__hip_atomic_load(&cnt[e], __ATOMIC_RELAXED, __HIP_MEMORY_SCOPE_AGENT) + 255u) >> 8); for (int j = 0; j < n; ++j) tb[64 + a + j] = e; a += n; } tb[32] = a; }
    __syncthreads();
}
__device__ __forceinline__ void phase_fill(const Ctx& X, LAS int* tb, const int wv) {
    moe_table(X, tb, wv);
    const int tid = tid_(wv); const int gtid = blockIdx.x * blockDim.x + tid, gsz = gridDim.x * blockDim.x;
    const int* sele = (const int*)X.misc(M_SELE); const float* selw = (const float*)X.misc(M_SELW); const int* selp = (const int*)X.misc(M_SELP);
    int* sot = (int*)X.misc(M_SOT); int* tos = (int*)X.misc(M_TOS); float* wos = (float*)X.misc(M_WOS); float* rss = (float*)X.misc(M_RSS); const float* rs2 = (const float*)X.misc(M_RS2);
    const unsigned* cnt = X.ctl() + CW_CNT + 64 * X.l;
    for (int t = gtid; t < T; t += gsz) {
        const int ee = sele[t]; const float rsn = rs2[t];
#pragma unroll
        for (int k = 0; k < 2; ++k) { const int e = (ee >> (8 * k)) & 255; const int slot = tb[e] * 256 + selp[2 * t + k]; sot[2 * t + k] = slot; tos[slot] = t; wos[slot] = selw[2 * t + k]; rss[slot] = rsn; }
    }
    for (int it = gtid; it < 32 * 256; it += gsz) { const int e = it >> 8, j = it & 255; const int c = (int)cnt[e]; const int padn = ((c + 255) & ~255) - c;
        if (j < padn) { const int slot = tb[e] * 256 + c + j; tos[slot] = 0; wos[slot] = 0.f; rss[slot] = 0.f; } }
}

constexpr int NPH = 16;
constexpr int LDS_BYTES = 147456;
constexpr int LDS_MISC = 131072;

__global__ void __launch_bounds__(512, 2) mega(Params p) {
    extern __shared__ __attribute__((aligned(16))) unsigned char lds[];
    LAS unsigned char* L = (LAS unsigned char*)lds;
    volatile LAS unsigned* MISC = (volatile LAS unsigned*)(L + LDS_MISC);
    LAS int* tb = (LAS int*)(L + LDS_MISC + 64);
    LAS float* scr = (LAS float*)(L + LDS_MISC + 2048);
    const int wv = __builtin_amdgcn_readfirstlane(threadIdx.x >> 6);
    if (threadIdx.x < 4) MISC[threadIdx.x] = 0u;
    __syncthreads();
    XcdBarrier bar; bar.bar = (unsigned*)(p.ws + WS_CTL) + CW_BAR; bar.x = 0; bar.st = MISC;
    if (!MK_MULTI) bar = xcd_barrier_post(bar.bar, MISC, wv);
    Ctx X; for (int i = 0; i < 26; ++i) X.in[i] = p.in[i]; X.out = p.out; X.ws = p.ws; X.l = 0;
    const int G = gridDim.x, c = blockIdx.x;
#ifndef PH_MASK
#define PH_MASK 0x1ffffu
#endif
#define IN(g) (((PH_MASK >> ((g) % NPH + ((g) == NPH * NL ? NPH : 0))) & 1u) && p.gp_lo <= (g) && (g) < p.gp_hi)
#ifndef FAST_MASK
#define FAST_MASK 0xffffu
#endif
#ifndef REPEAT_MASK
#define REPEAT_MASK 0u
#endif
#define REP(ph) for (int rep_ = 0; rep_ < (((REPEAT_MASK >> (ph)) & 1u) ? 2 : 1); ++rep_)
#define GEMM(ph, KM, S) do { REP(ph) { if ((FAST_MASK >> (ph)) & 1u) gemm_fast<KM, (ph) == 14 || (ph) == 3>(L, S, E, wv); else gemm_naive<KM>(S, E, wv); } } while (0)
#define SEAM(g) do { if (!MK_MULTI && IN((g) + 1)) xcd_barrier(bar, wv); } while (0)
#define DO_LAYER(LL) { constexpr int l = (LL); \
        X.l = l; const int g0 = NPH * l; \
        Epi E; E.X.ws = p.ws; E.X.out = p.out; E.xres = p.in[0]; E.xresb = (l == 0) ? nullptr : (const bf16*)p.out; \
        if (IN(g0 + 0)) { \
            REP(0) phase_weights(X, L, wv); \
            phase_norm(X, p.in[0], l > 0, X.inp(2, D), X.act(A_HB), (unsigned char*)p.out + HB8_OFF, wv); \
            SEAM(g0 + 0); \
        } \
        if (IN(g0 + 1)) { SchedG1A S{X.act(A_HB), X.w(W_IN), G, c}; GEMM(1, ((1u << K_LAT) | (1u << K_SGU) | (1u << K_ZT) | (1u << K_VT)), S); SEAM(g0 + 1); } \
        if (IN(g0 + 2)) { REP(2) phase_sgu(X, scr, wv); SEAM(g0 + 2); } \
        if (IN(g0 + 3)) { SchedF2G34 S{SchedF2{(const bf16*)(p.ws + WS_DFT), X.act(A_ZF), G, c}, SchedG34{X.act(A_LAT), X.w(W_UQ), X.w(W_UKV), G, c}, G, c}; GEMM(3, ((1u << K_FNET) | (1u << K_QRAW) | (1u << K_KVRAW)), S); SEAM(g0 + 4); } \
        if (IN(g0 + 5)) { phase_prep(X, wv); SEAM(g0 + 5); } \
        if (IN(g0 + 6)) { REP(6) { if ((FAST_MASK >> 6) & 1u) phase_attn_fast(X, (char*)lds, L, wv); else phase_attn_naive(X, wv); } SEAM(g0 + 6); } \
        if (IN(g0 + 8)) { for (int tl = c; tl < 512; tl += G) { int gr = c * 256; asm volatile("" : "+s"(gr)); SchedGate S1{(const bf16*)((const unsigned char*)p.out + HB8_OFF), X.w(W_G), tl, gr}; GEMM(8, ((1u << K_GATE)), S1); SchedMerge S2{X.act(A_YAS), X.act(A_ZRI), X.w(W_P), tl, gr}; GEMM(8, ((1u << K_MERGE)), S2); } SEAM(g0 + 8); } \
        if (IN(g0 + 9)) { SchedG6 S{X.act(A_MERGED), X.w(W_O), G, c, K_OUT, 4}; GEMM(9, ((1u << K_OUT)), S); SEAM(g0 + 9); } \
        if (IN(g0 + 11)) { SchedRT S{X.act(A_XB), X.w(W_R), G, c}; GEMM(11, ((1u << K_ROUTER)), S); SEAM(g0 + 11); } \
        if (IN(g0 + 12)) { phase_select(X, (LAS unsigned*)scr, wv); SEAM(g0 + 12); } \
        if (IN(g0 + 13)) { phase_fill(X, tb, wv); SEAM(g0 + 13); } \
        if (IN(g0 + 14)) { moe_table(X, tb, wv); SchedM1 S{X.act(A_XB), X.w(W_13), (const int*)X.misc(M_TOS), tb, G, c}; GEMM(14, ((1u << K_M1)), S); SEAM(g0 + 14); } \
        if (IN(g0 + 15)) { moe_table(X, tb, wv); SchedM2 S{X.act(A_HID), X.w(W_2), tb, G, c}; GEMM(15, ((1u << K_M2)), S); SEAM(g0 + 15); } \
    }
    DO_LAYER(0)
    DO_LAYER(1)
#undef DO_LAYER
    if (IN(NPH * NL)) { X.l = NL - 1; phase_norm(X, nullptr, 1, nullptr, nullptr, nullptr, wv); }
#undef IN
#undef SEAM
}

extern "C" void kernel_launch(void* const* d_in, const int* in_sizes, int n_in, void* d_out, int out_size, void* d_ws, size_t ws_size, hipStream_t stream) {
    static int ok = 0, grid = 256;
    if (ok == 0) {
        ok = 1;
        { int dev = 0, cus = 0; if (hipGetDevice(&dev) == hipSuccess && hipDeviceGetAttribute(&cus, hipDeviceAttributeMultiprocessorCount, dev) == hipSuccess && cus > 0) grid = cus; }
        if (n_in != 26 || in_sizes[0] != T * D || out_size != T * D || ws_size < WS_NEED) { fprintf(stderr, "kernel_launch: unexpected shapes (n_in %d, in0 %d, out %d, ws %zu < %zu)\n", n_in, n_in > 0 ? in_sizes[0] : -1, out_size, ws_size, (size_t)WS_NEED); ok = -1; }
        else if (hipFuncSetAttribute((const void*)mega, hipFuncAttributeMaxDynamicSharedMemorySize, LDS_BYTES) != hipSuccess) { fprintf(stderr, "kernel_launch: hipFuncSetAttribute failed\n"); ok = -1; }
    }
    if (ok < 0) return;
    (void)hipMemsetAsync((char*)d_ws + WS_CTL, 0, CTL_BYTES, stream);
    Params p{};
    for (int i = 0; i < 26; ++i) p.in[i] = (const float*)d_in[i];
    p.out = (float*)d_out; p.ws = (unsigned char*)d_ws;
#if MK_MULTI
    for (int g = 0; g <= NPH * NL; ++g) { p.gp_lo = g; p.gp_hi = g + 1; hipLaunchKernelGGL(mega, dim3(grid), dim3(512), LDS_BYTES, stream, p); }
#else
    p.gp_lo = 0; p.gp_hi = NPH * NL + 1; hipLaunchKernelGGL(mega, dim3(grid), dim3(512), LDS_BYTES, stream, p);
#endif
}
```

```cpp
#include <hip/hip_runtime.h>
#include <cstdio>
#include <cstdint>
#include <cmath>

#ifndef MK_MULTI
#define MK_MULTI 0
#endif

#define LAS __attribute__((address_space(3)))
typedef unsigned short bf16;
typedef short bf16x8 __attribute__((ext_vector_type(8)));
typedef float f32x4 __attribute__((ext_vector_type(4)));
typedef unsigned u32x4 __attribute__((ext_vector_type(4)));
typedef unsigned u32x2 __attribute__((ext_vector_type(2)));

constexpr int D = 1024, NB = 8, SEQ = 4096, T = NB * SEQ, NL = 2;
constexpr int NH = 8, QKN = 64, QKR = 32, QKH = 96, VH = 64, QL = 384, KVL = 256;
constexpr int NIN = 5280, C_SGU = 672, C_FN = 1696, C_GATE = 2208;
constexpr int NE = 32, EPG = 8, NG = 4, DE = 256;
constexpr float EPS = 1e-6f;
constexpr int NSLOT = 73728;
__device__ constexpr float ROPE_INV[16] = {1.000000000e+00f, 5.623413324e-01f, 3.162277639e-01f, 1.778279394e-01f, 1.000000015e-01f, 5.623412877e-02f, 3.162277862e-02f, 1.778279431e-02f,
    9.999999776e-03f, 5.623413250e-03f, 3.162277862e-03f, 1.778279431e-03f, 1.000000047e-03f, 5.623413017e-04f, 3.162277862e-04f, 1.778279402e-04f};
constexpr float QSCALE = 0.10206207261596577f * 1.4426950408889634f;

constexpr size_t MiB = 1ull << 20;
constexpr size_t WS_CTL = 0, CTL_BYTES = 128 * 1024;
constexpr int CW_BAR = 4096;
constexpr int CW_CNT = 16384;
constexpr size_t WS_W = 1 * MiB;
constexpr size_t W_IN = 0;
constexpr size_t W_G = W_IN + 2304ull * 1024 * 2;
constexpr size_t W_UQ = W_G + 3072ull * 1024 * 2;
constexpr size_t W_UKV = W_UQ + 768ull * 384 * 2;
constexpr size_t W_P = W_UKV + 1024ull * 384 * 2;
constexpr size_t W_O = W_P + 1024ull * 2048 * 2;
constexpr size_t W_R = W_O + 1024ull * 1024 * 2;
constexpr size_t W_S = W_R + 256ull * 1024 * 2;
constexpr size_t W_13 = W_S + 8ull * 128 * 128 * 2;
constexpr size_t W_2 = W_13 + 32ull * 512 * 1024 * 2;
constexpr size_t W_END = W_2 + 32ull * 1024 * 256 * 2;
static_assert(W_END <= 67 * MiB, "weights region");
constexpr size_t WS_DFT = 68 * MiB;
constexpr size_t WS_ACT = 100 * MiB;
constexpr size_t A_HB = 0 * MiB;
constexpr size_t A_MERGED = 296 * MiB;
constexpr size_t A_XB = 64 * MiB;
constexpr size_t A_YAS = 64 * MiB;
constexpr size_t A_ZRI = 128 * MiB;
constexpr size_t A_HID = 128 * MiB;
constexpr size_t A_LOG = 168 * MiB;
constexpr size_t A_LAT = 192 * MiB;
constexpr size_t A_SGU = 240 * MiB;
constexpr size_t A_VT = 272 * MiB;
constexpr size_t A_ZT = 304 * MiB;
constexpr int KF = 1152;
constexpr size_t A_ZF = 336 * MiB;
constexpr size_t A_Q = 240 * MiB;
constexpr size_t A_KV = 288 * MiB;
constexpr size_t A_KB = 352 * MiB;
constexpr size_t A_GATE = 192 * MiB;
constexpr size_t A_YSLOT = 192 * MiB;
constexpr size_t ACT_END = 400 * MiB;
constexpr size_t HB8_OFF = 64 * MiB;
constexpr size_t WS_MISC = WS_ACT + ACT_END;
constexpr size_t M_RSQ = 0, M_RSKV = M_RSQ + (size_t)T * 4;
constexpr size_t M_SELE = M_RSKV + (size_t)T * 4;
constexpr size_t M_SELW = M_SELE + (size_t)T * 4;
constexpr size_t M_SELP = M_SELW + (size_t)T * 8;
constexpr size_t M_SOT = M_SELP + (size_t)T * 8;
constexpr size_t M_TOS = M_SOT + (size_t)T * 8;
constexpr size_t M_WOS = M_TOS + (size_t)NSLOT * 4;
constexpr size_t M_RSS = M_WOS + (size_t)NSLOT * 4;
constexpr size_t M_SSP = M_RSS + (size_t)NSLOT * 4;
constexpr size_t M_RS2 = M_SSP + (size_t)T * 64;
constexpr size_t M_CS = M_RS2 + (size_t)T * 4;
constexpr size_t M_SN = M_CS + (size_t)T * 64;
constexpr size_t M_GMK = M_SN + (size_t)T * 64;
constexpr size_t M_END = M_GMK + 256;
constexpr size_t WS_NEED = WS_MISC + M_END;
static_assert(WS_NEED <= 512 * MiB, "workspace");

__device__ __forceinline__ int tid_(int wv) { unsigned z = 0u; asm volatile("" : "+v"(z));
    return wv * 64 + (int)__builtin_amdgcn_mbcnt_hi(~0u, __builtin_amdgcn_mbcnt_lo(~0u, z)); }
__device__ __forceinline__ float bf2f(unsigned b) { return __uint_as_float(b << 16); }
__device__ __forceinline__ unsigned pk2(float lo, float hi) { unsigned r; asm("v_cvt_pk_bf16_f32 %0, %1, %2" : "=v"(r) : "v"(lo), "v"(hi)); return r; }
__device__ __forceinline__ unsigned f2bf(float f) { return pk2(f, 0.0f); }
__device__ __forceinline__ float wave_sum(float v) {
#pragma unroll
    for (int o = 1; o < 64; o <<= 1) v += __shfl_xor(v, o);
    return v;
}
__device__ __forceinline__ float gelu_tanh(float x) {
    const float u = 0.7978845608028654f * (x + 0.044715f * x * x * x);
    const float e = __builtin_amdgcn_exp2f(2.8853900817779268f * u);
    return x - x * __builtin_amdgcn_rcpf(e + 1.0f);
}
__device__ __forceinline__ float sigmoidf_(float x) { return __builtin_amdgcn_rcpf(1.0f + __builtin_amdgcn_exp2f(-1.4426950408889634f * x)); }
constexpr float GATE_S = 32.0f;
__device__ __forceinline__ float gate_sig(float x) { return fminf(1.0f + __builtin_amdgcn_exp2f((-1.4426950408889634f / GATE_S) * x), 1e30f); }
__device__ __forceinline__ unsigned pk4f8(float a, float b, float c, float d) { unsigned w = 0u; w = __builtin_amdgcn_cvt_pk_fp8_f32(a, b, w, false); w = __builtin_amdgcn_cvt_pk_fp8_f32(c, d, w, true); return w; }

#define XB_TMO      128
#define XB_XCNT(j)  (256  + 64 * (j))
#define XB_XSUB(j)  (1280 + 64 * (j))
#define XB_XGEN(j)  (2304 + 64 * (j))
#define XB_TOP      3328
#define XB_TOPGEN   3392
#define XCD_BAR_WORDS 3456
#define XB_SPIN_CAP (1u << 18)
__device__ __forceinline__ unsigned xb_ld(unsigned* p)              { return __hip_atomic_load(p, __ATOMIC_RELAXED, __HIP_MEMORY_SCOPE_AGENT); }
__device__ __forceinline__ unsigned xb_add(unsigned* p, unsigned v) { return __hip_atomic_fetch_add(p, v, __ATOMIC_RELAXED, __HIP_MEMORY_SCOPE_AGENT); }
__device__ __forceinline__ unsigned xb_xcc_id() { return (unsigned)__builtin_amdgcn_s_getreg((3 << 11) | 20) & 0xFu; }
#define XB_SPIN(cond, bar) do { unsigned _sp = 0; while (cond) { __builtin_amdgcn_s_sleep(1); \
    if ((++_sp & 255u) == 0u) { if (xb_ld(&(bar)[XB_TMO])) break; if (_sp > XB_SPIN_CAP) { atomicAdd(&(bar)[XB_TMO], 1u); break; } } } } while (0)
struct XcdBarrier { unsigned* bar; unsigned x; volatile LAS unsigned* st; };
__device__ __forceinline__ XcdBarrier xcd_barrier_post(unsigned* bar, volatile LAS unsigned* st, const int wv) {
    XcdBarrier b; b.bar = bar; b.x = xb_xcc_id(); b.st = st;
    if (tid_(wv) == 0) (void)xb_add(&bar[XB_XCNT(b.x)], 1u);
    return b;
}
__device__ __forceinline__ void xcd_barrier_complete(unsigned* bar, unsigned x, unsigned& nloc, unsigned& nx) {
    const unsigned G = gridDim.x * gridDim.y * gridDim.z;
    unsigned sum, cnt, mine, sp = 0u;
    for (;;) {
        sum = 0u; cnt = 0u; mine = 0u;
#pragma unroll
        for (unsigned j = 0; j < 16; ++j) { const unsigned c = xb_ld(&bar[XB_XCNT(j)]); sum += c; cnt += (c > 0u) ? 1u : 0u; mine = (j == x) ? c : mine; }
        if (sum == G) break;
        __builtin_amdgcn_s_sleep(1);
        if ((++sp & 255u) == 0u) { if (xb_ld(&bar[XB_TMO])) break; if (sp > XB_SPIN_CAP) { atomicAdd(&bar[XB_TMO], 1u); break; } }
    }
    nloc = mine > 0u ? mine : 1u; nx = cnt > 0u ? cnt : 1u;
}
__device__ __forceinline__ void xcd_barrier(const XcdBarrier& b, const int wv) {
    asm volatile("s_waitcnt vmcnt(0)" ::: "memory");
    __syncthreads();
    if (tid_(wv) == 0) {
        unsigned* bar = b.bar;
        __builtin_amdgcn_s_waitcnt(0);
        unsigned nloc = b.st[0], nx = b.st[1];
        if (nloc == 0u) { xcd_barrier_complete(bar, b.x, nloc, nx); b.st[0] = nloc; b.st[1] = nx; }
        const unsigned old = xb_add(&bar[XB_XSUB(b.x)], 1u);
        const unsigned gen = old / nloc;
        if (old + 1u == (gen + 1u) * nloc) {
            __builtin_amdgcn_fence(__ATOMIC_RELEASE, "agent");
            asm volatile("s_waitcnt vmcnt(0)" ::: "memory");
            const unsigned og = xb_add(&bar[XB_TOP], 1u);
            const unsigned tg = og / nx;
            if (og + 1u == (tg + 1u) * nx) xb_add(&bar[XB_TOPGEN], 1u);
            else XB_SPIN(xb_ld(&bar[XB_TOPGEN]) == tg, bar);
            __builtin_amdgcn_fence(__ATOMIC_ACQUIRE, "agent");
            xb_add(&bar[XB_XGEN(b.x)], 1u);
            asm volatile("s_waitcnt vmcnt(0)" ::: "memory");
        } else {
            XB_SPIN(xb_ld(&bar[XB_XGEN(b.x)]) == gen, bar);
            __builtin_amdgcn_fence(__ATOMIC_ACQUIRE, "agent");
            asm volatile("s_waitcnt vmcnt(0)" ::: "memory");
        }
    }
    __syncthreads();
}

struct Params { const float* in[26]; float* out; unsigned char* ws; int gp_lo, gp_hi; };

struct Ctx {
    const float* in[26]; float* out; unsigned char* ws; int l;
    __device__ __forceinline__ const float* inp(int i, size_t per_layer) const { return in[i] + (size_t)l * per_layer; }
    __device__ __forceinline__ bf16* w(size_t off) const { return (bf16*)(ws + WS_W + off); }
    __device__ __forceinline__ bf16* act(size_t off) const { return (bf16*)(ws + WS_ACT + off); }
    __device__ __forceinline__ unsigned char* misc(size_t off) const { return ws + WS_MISC + off; }
    __device__ __forceinline__ unsigned* ctl() const { return (unsigned*)(ws + WS_CTL); }
};

enum { K_LAT = 0, K_SGU, K_ZT, K_GATE, K_QRAW, K_KVRAW, K_FNET, K_MERGE, K_OUT, K_ROUTER, K_M1, K_M2, K_VT };
struct GU {
    const bf16* A; const bf16* B;
    const int* arow;
    int lda, ldb, K;
    int kind, r0, c0, aux;
    int chain;
};

struct Epi {
    const float* xres; const bf16* xresb;
    struct { unsigned char* ws; float* out;
        __device__ __forceinline__ bf16* act(size_t off) const { return (bf16*)(ws + WS_ACT + off); }
        __device__ __forceinline__ unsigned char* misc(size_t off) const { return ws + WS_MISC + off; } } X;
    __device__ __forceinline__ void st4(bf16* p, f32x4 v) const { u32x2 w; w.x = pk2(v[0], v[1]); w.y = pk2(v[2], v[3]); *(u32x2*)p = w; }
    struct Pre { u32x4 a, b; };
    template <unsigned KM> __device__ __forceinline__ void prefetch(const GU& u, int r, int c, Pre& P) const {
        const int row = u.r0 + r, col = u.c0 + c;
        if ((KM & (1u << K_OUT)) && u.kind == K_OUT) { const size_t o = (size_t)row * 1024 + col;
            if (xresb) { const u32x2 a = *(const u32x2*)(xresb + o), b = *(const u32x2*)(xresb + o + 128); P.a = (u32x4){a.x << 16, a.x & 0xffff0000u, a.y << 16, a.y & 0xffff0000u}; P.b = (u32x4){b.x << 16, b.x & 0xffff0000u, b.y << 16, b.y & 0xffff0000u}; }
            else { P.a = *(const u32x4*)(xres + o); P.b = *(const u32x4*)(xres + o + 128); } }
        if ((KM & ((1u << K_QRAW) | (1u << K_KVRAW))) && (u.kind == K_QRAW || u.kind == K_KVRAW)) P.a.x = __float_as_uint(((const float*)X.misc(u.kind == K_QRAW ? M_RSQ : M_RSKV))[row]);
        if ((KM & (1u << K_M1)) && u.kind == K_M1) { P.a.x = __float_as_uint(((const float*)X.misc(M_WOS))[row]); P.a.y = __float_as_uint(((const float*)X.misc(M_RSS))[row]); }
        if ((KM & (1u << K_MERGE)) && u.kind == K_MERGE) { const bf16* g = X.act(A_GATE) + (size_t)row * 768 + col + (u.aux & 3) * 256; const int nx = (u.aux & 3) < 2 ? 256 : 0;
            const u32x2 gl = *(const u32x2*)(g), gh = *(const u32x2*)(g + 128), nl = *(const u32x2*)(g + nx), nh = *(const u32x2*)(g + nx + 128);
            P.a = (u32x4){gl.x, gl.y, gh.x, gh.y}; P.b = (u32x4){nl.x, nl.y, nh.x, nh.y}; }
    }
    template <unsigned KM> __device__ __forceinline__ void run(const GU& u, int r, int c, f32x4& lo, f32x4& hi, const Pre& P) const {
        const int row = u.r0 + r, col = u.c0 + c;
        switch (u.kind) {
        case K_LAT: if (KM & (1u << K_LAT)) { bf16* p = X.act(A_LAT) + (size_t)row * 768 + col; st4(p, lo); st4(p + 128, hi); } break;
        case K_VT: if (KM & (1u << K_VT)) {
            const int b = col >> 12, pos = col & 4095;
            bf16* p = X.act(A_VT) + ((size_t)(b * 512 + row) * 4096) + pos;
            f32x4 a, b2;
#pragma unroll
            for (int j = 0; j < 4; ++j) { a[j] = gelu_tanh(lo[j]); b2[j] = gelu_tanh(hi[j]); }
            st4(p, a); st4(p + 128, b2); } break;
        case K_SGU: if (KM & (1u << K_SGU)) { bf16* p = X.act(A_SGU) + (size_t)row * 512 + col;
            f32x4 a, b;
#pragma unroll
            for (int j = 0; j < 4; ++j) { a[j] = gelu_tanh(lo[j]); b[j] = gelu_tanh(hi[j]); }
            st4(p, a); st4(p + 128, b); } break;
        case K_ZT: if (KM & (1u << K_ZT)) {
            bf16* p = X.act(A_ZT) + ((size_t)((col >> 12) * 512 + row) * 4096) + (col & 4095); st4(p, lo); st4(p + 128, hi); } break;
        case K_GATE: if (KM & (1u << K_GATE)) {
            bf16* g = X.act(A_GATE) + (size_t)row * 768 + col + u.aux * 256;
            f32x4 a, b;
#pragma unroll
            for (int j = 0; j < 4; ++j) { a[j] = gate_sig(lo[j]); b[j] = gate_sig(hi[j]); }
            st4(g, a); st4(g + 128, b); } break;
        case K_QRAW: if (KM & (1u << K_QRAW)) { bf16* p = X.act(A_Q) + (size_t)row * 768 + col; st4(p, lo); st4(p + 128, hi); } break;
        case K_KVRAW: if (KM & (1u << K_KVRAW)) { bf16* p = X.act(A_KV) + (size_t)row * 1024 + col; st4(p, lo); st4(p + 128, hi); } break;
        case K_FNET: if (KM & (1u << K_FNET)) {
            const int b = u.aux >> 2, part = (u.aux >> 1) & 1, k = 2 * row + (u.aux & 1); bf16* p = X.act(A_ZRI) + ((size_t)b * 4096 + k) * 1024 + part * 512 + col; st4(p, lo); st4(p + 128, hi);
            if (k > 0) { bf16* q = X.act(A_ZRI) + ((size_t)b * 4096 + 4096 - k) * 1024 + part * 512 + col; if (part) { st4(q, -lo); st4(q + 128, -hi); } else { st4(q, lo); st4(q + 128, hi); } } } break;
        case K_MERGE: if (KM & (1u << K_MERGE)) {
            f32x4 cl, ch_, dl, dh;
            cl[0] = bf2f(P.a.x & 0xffffu); cl[1] = bf2f(P.a.x >> 16); cl[2] = bf2f(P.a.y & 0xffffu); cl[3] = bf2f(P.a.y >> 16);
            ch_[0] = bf2f(P.a.z & 0xffffu); ch_[1] = bf2f(P.a.z >> 16); ch_[2] = bf2f(P.a.w & 0xffffu); ch_[3] = bf2f(P.a.w >> 16);
            dl[0] = bf2f(P.b.x & 0xffffu); dl[1] = bf2f(P.b.x >> 16); dl[2] = bf2f(P.b.y & 0xffffu); dl[3] = bf2f(P.b.y >> 16);
            dh[0] = bf2f(P.b.z & 0xffffu); dh[1] = bf2f(P.b.z >> 16); dh[2] = bf2f(P.b.w & 0xffffu); dh[3] = bf2f(P.b.w >> 16);
            if ((u.aux & 3) < 2) {
#pragma unroll
                for (int j = 0; j < 4; ++j) { lo[j] *= dl[j] * __builtin_amdgcn_rcpf(cl[j]); hi[j] *= dh[j] * __builtin_amdgcn_rcpf(ch_[j]); }
            } else { bf16* p = X.act(A_MERGED) + (size_t)(((u.aux >> 8) & 0xfff) * 256 + r) * 1024 + (u.aux >> 20) * 256 + c; f32x4 ol, oh;
#pragma unroll
                for (int j = 0; j < 4; ++j) { ol[j] = lo[j] * __builtin_amdgcn_rcpf(cl[j]); oh[j] = hi[j] * __builtin_amdgcn_rcpf(ch_[j]); }
                st4(p, ol); st4(p + 128, oh); } } break;
        case K_OUT: if (KM & (1u << K_OUT)) { const size_t o = (size_t)row * 1024 + col;
            const f32x4 a = __builtin_bit_cast(f32x4, P.a), b = __builtin_bit_cast(f32x4, P.b);
            *(f32x4*)(X.out + o) = a + lo; *(f32x4*)(X.out + o + 128) = b + hi; } break;
        case K_ROUTER: if (KM & (1u << K_ROUTER)) { if (col < 64) *(f32x4*)((float*)X.act(A_LOG) + (size_t)u.aux * T * 64 + (size_t)row * 64 + col) = lo; } break;
        case K_M1: if (KM & (1u << K_M1)) {
            const float wgt = __uint_as_float(P.a.x), rs = __uint_as_float(P.a.y);
            f32x4 h;
#pragma unroll
            for (int j = 0; j < 4; ++j) { const float a = lo[j] * rs; h[j] = a * sigmoidf_(a) * (hi[j] * rs) * wgt; }
            st4(X.act(A_HID) + (size_t)row * 256 + col, h); } break;
        case K_M2: if (KM & (1u << K_M2)) { bf16* p = X.act(A_YSLOT) + (size_t)row * 1024 + col; st4(p, lo); st4(p + 128, hi); } break;
        }
    }
    __device__ __forceinline__ void st8(bf16* p, f32x4 a, f32x4 b) const { u32x4 w; w.x = pk2(a[0], a[1]); w.y = pk2(a[2], a[3]); w.z = pk2(b[0], b[1]); w.w = pk2(b[2], b[3]); *(u32x4*)p = w; }
    template <unsigned KM> __device__ __forceinline__ void run8(const GU& u, int r, int c, f32x4& lo0, f32x4& lo1, f32x4& hi0, f32x4& hi1, const Pre& P0, const Pre& P1) const {
        const int row = u.r0 + r, col = u.c0 + c; bf16* p = nullptr; int act = 0;
        constexpr unsigned PLAIN = (1u << K_LAT) | (1u << K_SGU) | (1u << K_ZT) | (1u << K_VT) | (1u << K_QRAW) | (1u << K_KVRAW) | (1u << K_FNET) | (1u << K_M2);
        if ((KM & PLAIN) && ((PLAIN >> u.kind) & 1u)) {
            switch (u.kind) {
            case K_LAT: if (KM & (1u << K_LAT)) p = X.act(A_LAT) + (size_t)row * 768 + col; break;
            case K_SGU: if (KM & (1u << K_SGU)) { p = X.act(A_SGU) + (size_t)row * 512 + col; act = 1; } break;
            case K_ZT: if (KM & (1u << K_ZT)) p = X.act(A_ZT) + ((size_t)((col >> 12) * 512 + row) * 4096) + (col & 4095); break;
            case K_VT: if (KM & (1u << K_VT)) { p = X.act(A_VT) + ((size_t)((col >> 12) * 512 + row) * 4096) + (col & 4095); act = 1; } break;
            case K_QRAW: if (KM & (1u << K_QRAW)) { p = X.act(A_Q) + (size_t)row * 768 + col; act = 3; } break;
            case K_KVRAW: if (KM & (1u << K_KVRAW)) { p = X.act(A_KV) + (size_t)row * 1024 + col; act = 4; } break;
            case K_FNET: if (KM & (1u << K_FNET)) p = X.act(A_ZRI) + ((size_t)(u.aux >> 2) * 4096 + 2 * row + (u.aux & 1)) * 1024 + ((u.aux >> 1) & 1) * 512 + col; break;
            case K_M2: if (KM & (1u << K_M2)) p = X.act(A_YSLOT) + (size_t)row * 1024 + col; break;
            }
            f32x4 a0 = lo0, a1 = lo1, b0 = hi0, b1 = hi1;
            if ((KM & ((1u << K_SGU) | (1u << K_VT))) && act == 1) {
#pragma unroll
                for (int j = 0; j < 4; ++j) { a0[j] = gelu_tanh(a0[j]); a1[j] = gelu_tanh(a1[j]); b0[j] = gelu_tanh(b0[j]); b1[j] = gelu_tanh(b1[j]); } }
            if ((KM & ((1u << K_QRAW) | (1u << K_KVRAW))) && act >= 3) { const float rs = __uint_as_float(P0.a.x); a0 *= rs; a1 *= rs; b0 *= rs; b1 *= rs; }
            st8(p, a0, a1); st8(p + 128, b0, b1);
            if ((KM & (1u << K_FNET)) && u.kind == K_FNET && (2 * row + (u.aux & 1)) > 0) {
                bf16* q = X.act(A_ZRI) + ((size_t)(u.aux >> 2) * 4096 + 4096 - (2 * row + (u.aux & 1))) * 1024 + ((u.aux >> 1) & 1) * 512 + col;
                if (u.aux & 2) { a0 = -a0; a1 = -a1; b0 = -b0; b1 = -b1; }
                st8(q, a0, a1); st8(q + 128, b0, b1); }
        } else if ((KM & (1u << K_OUT)) && u.kind == K_OUT) {
            const size_t o = (size_t)row * 1024 + col;
            const f32x4 x0 = __builtin_bit_cast(f32x4, P0.a) + lo0, x1 = __builtin_bit_cast(f32x4, P1.a) + lo1, y0 = __builtin_bit_cast(f32x4, P0.b) + hi0, y1 = __builtin_bit_cast(f32x4, P1.b) + hi1;
            bf16* xb = X.act(A_XB) + o; st8(xb, x0, x1); st8(xb + 128, y0, y1);
            float ss = 0.f;
#pragma unroll
            for (int j = 0; j < 4; ++j) ss += x0[j] * x0[j] + x1[j] * x1[j] + y0[j] * y0[j] + y1[j] * y1[j];
            ss += __shfl_xor(ss, 16); ss += __shfl_xor(ss, 32);
            if ((c & 24) == 0) ((float*)X.misc(M_SSP))[(size_t)row * 16 + (u.c0 >> 8) * 4 + (c >> 5)] = ss;
        } else if ((KM & (1u << K_GATE)) && u.kind == K_GATE) {
            f32x4 a0, a1, b0, b1;
#pragma unroll
            for (int j = 0; j < 4; ++j) { a0[j] = gate_sig(lo0[j]); a1[j] = gate_sig(lo1[j]); b0[j] = gate_sig(hi0[j]); b1[j] = gate_sig(hi1[j]); }
            bf16* g = X.act(A_GATE) + (size_t)row * 768 + col + u.aux * 256;
            st8(g, a0, a1); st8(g + 128, b0, b1);
        } else { run<KM>(u, r, c, lo0, hi0, P0); run<KM>(u, r, c + 4, lo1, hi1, P1); }
    }
};

template <unsigned KM, class Sched>
__device__ __forceinline__ void gemm_naive(const Sched& S, const Epi& E, const int wv) {
    const int tid = tid_(wv); const int lane = tid & 63, wid = tid >> 6, fr = lane & 15, fq = lane >> 4;
    f32x4 acc[2][16];
    GU u;
    for (int i = 0; S.next(i, u); ++i) {
        if (!u.chain) {
#pragma unroll
            for (int mi = 0; mi < 2; ++mi)
#pragma unroll
                for (int ni = 0; ni < 16; ++ni) acc[mi][ni] = (f32x4){0.f, 0.f, 0.f, 0.f};
        }
        const bf16* ap[2];
#pragma unroll
        for (int mi = 0; mi < 2; ++mi) { const int r = 32 * wid + 16 * mi + fr; const size_t rr = u.arow ? (size_t)u.arow[r] : (size_t)r; ap[mi] = u.A + rr * u.lda + 8 * fq; }
        const bf16* bp = u.B + (size_t)fr * u.ldb + 8 * fq;
        for (int k0 = 0; k0 < u.K; k0 += 32) {
            const bf16x8 a0 = *(const bf16x8*)(ap[0] + k0), a1 = *(const bf16x8*)(ap[1] + k0);
#pragma unroll
            for (int ni = 0; ni < 16; ++ni) {
                const bf16x8 b = *(const bf16x8*)(bp + (size_t)(16 * ni) * u.ldb + k0);
                acc[0][ni] = __builtin_amdgcn_mfma_f32_16x16x32_bf16(b, a0, acc[0][ni], 0, 0, 0);
                acc[1][ni] = __builtin_amdgcn_mfma_f32_16x16x32_bf16(b, a1, acc[1][ni], 0, 0, 0);
            }
        }
#pragma unroll
        for (int mi = 0; mi < 2; ++mi)
#pragma unroll
            for (int ni = 0; ni < 8; ++ni) { Epi::Pre P; E.template prefetch<KM>(u, 32 * wid + 16 * mi + fr, 16 * ni + 4 * fq, P); E.template run<KM>(u, 32 * wid + 16 * mi + fr, 16 * ni + 4 * fq, acc[mi][ni], acc[mi][ni + 8], P); }
    }
}

constexpr int BK = 64, HTB = 128 * BK * 2;
__host__ __device__ __forceinline__ int lds_byte(int r, int c) { const int st = (r >> 4) * 2 + (c >> 5), rr = r & 15, cc = c & 31, ob = rr * 64 + cc * 2; return st * 1024 + (ob ^ (((ob >> 9) & 1) << 5)); }
__host__ __device__ __forceinline__ void stage_rc(int b, int& R, int& C) { const int st = b / 1024, sb = b % 1024, swz = sb ^ (((sb >> 9) & 1) << 5); R = (st >> 1) * 16 + swz / 64; C = (st & 1) * 32 + (swz % 64) / 2; }
__host__ __device__ __forceinline__ int perm32(int rho) { const int n = rho >> 4, i = rho & 15; return 8 * (i >> 2) + 4 * n + (i & 3); }
struct StageOff { unsigned a[2][2], b[2]; };
__device__ __forceinline__ void stage_offsets(const GU& u, const int (&R)[2], const int (&C)[2], const int (&Rb)[2], StageOff& o) {
#pragma unroll
    for (int i = 0; i < 2; ++i) {
        o.b[i] = (unsigned)(Rb[i] * u.ldb + C[i]) * 2u;
#pragma unroll
        for (int h = 0; h < 2; ++h) { const int row = R[i] + 128 * h; const int sr = u.arow ? u.arow[row] : row; o.a[h][i] = (unsigned)(sr * u.lda + C[i]) * 2u; }
    }
}
template <unsigned KM, bool VAR, class Sched>
__device__ __forceinline__ void gemm_fast(LAS unsigned char* lds, const Sched& S, const Epi& E, const int wv) {
    const int tid = tid_(wv); const int wid = __builtin_amdgcn_readfirstlane(tid >> 6), lane = tid & 63, wr = wid >> 2, wc = wid & 3, fr = lane & 15, fq = lane >> 4;
    int R[2], C[2], Rb[2];
#pragma unroll
    for (int i = 0; i < 2; ++i) { stage_rc(tid * 16 + i * 8192, R[i], C[i]); Rb[i] = (R[i] & ~31) + perm32(R[i] & 31); }
    const size_t kstep = (size_t)(BK * 2);
    const unsigned ldsw = (unsigned)wid * 1024u;
    const int aoff = lds_byte(wr * 64 + fr, fq * 8), boff = lds_byte(wc * 32 + fr, fq * 8);
#define PG8_SA(b, h) (((b) * 2 + (h)) * HTB)
#define PG8_SB(b, h) ((4 + (b) * 2 + (h)) * HTB)
#define PG8_STAGE2(bufoff, gbase, v0, v1) do { \
        __builtin_amdgcn_global_load_lds((const unsigned*)((const char*)(gbase) + (v0)), (LAS unsigned*)(lds + (bufoff) + ldsw), 16, 0, 0); \
        __builtin_amdgcn_global_load_lds((const unsigned*)((const char*)(gbase) + (v1)), (LAS unsigned*)(lds + (bufoff) + ldsw + 8192), 16, 0, 0); } while (0)
#define PG8_LDA(dst, b, h) do { _Pragma("unroll") for (int m = 0; m < 4; ++m) _Pragma("unroll") for (int k = 0; k < 2; ++k) dst[m][k] = *(const LAS bf16x8*)(lds + PG8_SA(b, h) + aoff + m * 2048 + k * 1024); } while (0)
#define PG8_LDB(dst, b, h) do { _Pragma("unroll") for (int n = 0; n < 2; ++n) _Pragma("unroll") for (int k = 0; k < 2; ++k) dst[n][k] = *(const LAS bf16x8*)(lds + PG8_SB(b, h) + boff + n * 2048 + k * 1024); } while (0)
#define PG8_MMA(ai, bj, At, Bt) do { __builtin_amdgcn_s_setprio(1); _Pragma("unroll") for (int m = 0; m < 4; ++m) _Pragma("unroll") for (int n = 0; n < 2; ++n) _Pragma("unroll") for (int k = 0; k < 2; ++k) \
        acc[ai][bj][m][n] = __builtin_amdgcn_mfma_f32_16x16x32_bf16(Bt[n][k], At[m][k], acc[ai][bj][m][n], 0, 0, 0); __builtin_amdgcn_s_setprio(0); } while (0)
    typedef int i32x4_ __attribute__((ext_vector_type(4))); typedef int i32x8_ __attribute__((ext_vector_type(8)));
    constexpr bool F8 = (KM == (1u << K_GATE));
#define PG8_CAT(X0, X1) __builtin_shufflevector(__builtin_bit_cast(i32x4_, X0), __builtin_bit_cast(i32x4_, X1), 0, 1, 2, 3, 4, 5, 6, 7)
#define PG8_MMA8(ai, bj, At, Bt) do { __builtin_amdgcn_s_setprio(1); _Pragma("unroll") for (int m = 0; m < 4; ++m) _Pragma("unroll") for (int n = 0; n < 2; ++n) \
        { const i32x8_ b8_ = PG8_CAT(Bt[n][0], Bt[n][1]), a8_ = PG8_CAT(At[m][0], At[m][1]); asm volatile("v_mfma_f32_16x16x128_f8f6f4 %0, %1, %2, %0" : "+v"(acc[ai][bj][m][n]) : "v"(b8_), "v"(a8_)); }      \
        __builtin_amdgcn_s_setprio(0); } while (0)
#define PG8_MM(ai, bj, At, Bt) do { if (F8) PG8_MMA8(ai, bj, At, Bt); else PG8_MMA(ai, bj, At, Bt); } while (0)
#define PG8_WAIT_V(n) asm volatile("s_waitcnt vmcnt(" #n ")" ::: "memory")
#define PG8_WAIT_L(n) asm volatile("s_waitcnt lgkmcnt(" #n ")" ::: "memory")
#define PG8_BAR __builtin_amdgcn_s_barrier()
#define PG8_SCHED __builtin_amdgcn_sched_barrier(0)
    GU cur, nxt; int ui = 0;
    if (!S.next(0, cur)) return;
    StageOff co, no;
    stage_offsets(cur, R, C, Rb, co);
    f32x4 acc[2][2][4][2];
#pragma unroll
    for (int a = 0; a < 2; ++a)
#pragma unroll
        for (int b = 0; b < 2; ++b)
#pragma unroll
            for (int m = 0; m < 4; ++m)
#pragma unroll
                for (int n = 0; n < 2; ++n) acc[a][b][m][n] = (f32x4){0.f, 0.f, 0.f, 0.f};
    bf16x8 At[4][2], B0[2][2], B1[2][2];
    const char* cA = (const char*)cur.A; const char* cB = (const char*)cur.B; size_t chB = (size_t)cur.ldb * 256;
    PG8_STAGE2(PG8_SB(0, 0), cB, co.b[0], co.b[1]); PG8_STAGE2(PG8_SB(0, 1), cB + chB, co.b[0], co.b[1]); PG8_STAGE2(PG8_SA(0, 0), cA, co.a[0][0], co.a[0][1]); PG8_STAGE2(PG8_SA(0, 1), cA, co.a[1][0], co.a[1][1]);
    if (wr == 1) PG8_BAR;
    PG8_WAIT_V(2); PG8_BAR;
    PG8_STAGE2(PG8_SB(1, 0), cB + kstep, co.b[0], co.b[1]); PG8_STAGE2(PG8_SA(1, 0), cA + kstep, co.a[0][0], co.a[0][1]); PG8_STAGE2(PG8_SB(1, 1), cB + chB + kstep, co.b[0], co.b[1]);
    PG8_WAIT_V(6); PG8_BAR;
    for (;;) {
        const bool has_next = S.next(ui + 1, nxt);
        const char* nA = cA; const char* nB = cB; size_t nhB = chB; if (VAR) no = co;
        if (has_next) { nA = (const char*)nxt.A; nB = (const char*)nxt.B; if (VAR) { nhB = (size_t)nxt.ldb * 256; stage_offsets(nxt, R, C, Rb, no); } }
        const int nt = cur.K / BK;
#pragma nounroll
        for (int t = 0; t < nt; t += 2) {
            const bool last = (t == nt - 2);
            const char* a1 = cA + (size_t)(t + 1) * kstep;
            const char* a2 = last ? nA : cA + (size_t)(t + 2) * kstep; const char* b2 = last ? nB : cB + (size_t)(t + 2) * kstep;
            const char* a3 = a2 + kstep; const char* b3 = b2 + kstep;
            const size_t h2 = (VAR && last) ? nhB : chB;
            const unsigned va00 = (VAR && last) ? no.a[0][0] : co.a[0][0], va01 = (VAR && last) ? no.a[0][1] : co.a[0][1], va10 = (VAR && last) ? no.a[1][0] : co.a[1][0], va11 = (VAR && last) ? no.a[1][1] : co.a[1][1];
            const unsigned vb0 = (VAR && last) ? no.b[0] : co.b[0], vb1 = (VAR && last) ? no.b[1] : co.b[1];
            PG8_LDB(B0, 0, 0); PG8_LDB(B1, 0, 1); PG8_SCHED; PG8_LDA(At, 0, 0); PG8_STAGE2(PG8_SA(1, 1), a1, co.a[1][0], co.a[1][1]);
            PG8_WAIT_V(8); PG8_WAIT_L(0); PG8_BAR; PG8_MM(0, 0, At, B0); PG8_MM(0, 1, At, B1); PG8_BAR; PG8_SCHED;
            PG8_LDA(At, 0, 1); PG8_STAGE2(PG8_SB(0, 0), b2, vb0, vb1); PG8_STAGE2(PG8_SB(0, 1), b2 + h2, vb0, vb1); PG8_STAGE2(PG8_SA(0, 0), a2, va00, va01);
            PG8_WAIT_V(8); PG8_WAIT_L(0); PG8_BAR; PG8_MM(1, 0, At, B0); PG8_MM(1, 1, At, B1); PG8_BAR; PG8_SCHED;
            PG8_LDB(B0, 1, 0); PG8_LDB(B1, 1, 1); PG8_SCHED; PG8_LDA(At, 1, 0); PG8_STAGE2(PG8_SA(0, 1), a2, va10, va11);
            PG8_WAIT_V(8); PG8_WAIT_L(0); PG8_BAR; PG8_MM(0, 0, At, B0); PG8_MM(0, 1, At, B1); PG8_BAR; PG8_SCHED;
            PG8_LDA(At, 1, 1); PG8_STAGE2(PG8_SB(1, 0), b3, vb0, vb1); PG8_STAGE2(PG8_SB(1, 1), b3 + h2, vb0, vb1); PG8_STAGE2(PG8_SA(1, 0), a3, va00, va01);
            PG8_WAIT_V(8); PG8_WAIT_L(0); PG8_BAR; PG8_MM(1, 0, At, B0); PG8_MM(1, 1, At, B1); PG8_BAR; PG8_SCHED;
        }
        if (wr == 0) PG8_BAR;
        if (F8) asm volatile("s_nop 15\n\ts_nop 15" ::: "memory");
#pragma unroll
        for (int ai = 0; ai < 2; ++ai) {
            Epi::Pre P[4][2];
#pragma unroll
            for (int m = 0; m < 4; ++m)
#pragma unroll
                for (int n = 0; n < 2; ++n) E.template prefetch<KM>(cur, 128 * ai + 64 * wr + 16 * m + fr, 32 * wc + 8 * fq + 4 * n, P[m][n]);
            if (KM & ((1u << K_QRAW) | (1u << K_KVRAW) | (1u << K_M1))) {
#pragma unroll
                for (int m = 0; m < 4; ++m) { asm volatile("" : "+v"(P[m][0].a.x), "+v"(P[m][0].a.y)); if (KM & (1u << K_M1)) asm volatile("" : "+v"(P[m][1].a.x), "+v"(P[m][1].a.y)); }
            }
            if (KM & ((1u << K_OUT) | (1u << K_MERGE))) {
#pragma unroll
                for (int m = 0; m < 4; ++m)
#pragma unroll
                    for (int n = 0; n < 2; ++n) asm volatile("" : "+v"(P[m][n].a), "+v"(P[m][n].b));
            }
#pragma unroll
            for (int m = 0; m < 4; ++m) { E.template run8<KM>(cur, 128 * ai + 64 * wr + 16 * m + fr, 32 * wc + 8 * fq, acc[ai][0][m][0], acc[ai][0][m][1], acc[ai][1][m][0], acc[ai][1][m][1], P[m][0], P[m][1]);
                asm volatile("" ::: "memory"); }
        }
        if (!has_next) break;
        if (!nxt.chain) {
#pragma unroll
            for (int a = 0; a < 2; ++a)
#pragma unroll
                for (int b = 0; b < 2; ++b)
#pragma unroll
                    for (int m = 0; m < 4; ++m)
#pragma unroll
                        for (int n = 0; n < 2; ++n) acc[a][b][m][n] = (f32x4){0.f, 0.f, 0.f, 0.f};
        }
        cur = nxt; cA = nA; cB = nB; if (VAR) { chB = nhB; co = no; } ++ui;
        if (wr == 1) PG8_BAR;
    }
    PG8_WAIT_V(0);
    PG8_BAR;
#undef PG8_SA
#undef PG8_SB
#undef PG8_STAGE2
#undef PG8_LDA
#undef PG8_LDB
#undef PG8_MMA
#undef PG8_MMA8
#undef PG8_MM
#undef PG8_CAT
#undef PG8_WAIT_V
#undef PG8_WAIT_L
#undef PG8_BAR
#undef PG8_SCHED
}

__device__ __forceinline__ void order_map(int L, int nM, int nN, int& pm, int& pn) {
    const int nwg = nM * nN; int wgid = L;
    { const int q = nwg / 8, r = nwg % 8, xcd = wgid % 8, off = wgid / 8; wgid = (xcd < r ? xcd * (q + 1) : r * (q + 1) + (xcd - r) * q) + off; }
    const int nig = 8 * nN, gid = wgid / nig, fm = gid * 8, gsz = (nM - fm) < 8 ? (nM - fm) : 8;
    pm = fm + ((wgid % nig) % gsz); pn = (wgid % nig) / gsz;
}
struct SchedG1A {
    const bf16 *hb, *win; int G, c;
    __device__ __forceinline__ bool next(int i, GU& u) const {
        const int L = i * G + c; if (L >= 128 * 9) return false;
        u.arow = nullptr; u.lda = 1024; u.ldb = 1024; u.K = 1024; u.chain = 0; u.aux = 0;
        int pm, j; order_map(L, 128, 9, pm, j);
        if (j < 5) { u.A = hb + (size_t)pm * 256 * 1024; u.B = win + (size_t)j * 256 * 1024; u.r0 = pm * 256;
            if (j < 3) { u.kind = K_LAT; u.c0 = j * 256; } else { u.kind = K_SGU; u.c0 = (j - 3) * 256; } }
        else { u.A = win + (size_t)j * 256 * 1024; u.B = hb + (size_t)pm * 256 * 1024; u.c0 = pm * 256;
            if (j < 7) { u.kind = K_VT; u.r0 = (j - 5) * 256; } else { u.kind = K_ZT; u.r0 = (j - 7) * 256; } }
        return true;
    }
};
struct SchedG34 { const bf16 *lat, *wuq, *wukv; int G, c;
    __device__ __forceinline__ bool next(int i, GU& u) const {
        const int L = i * G + c; if (L >= 128 * 7) return false;
        int pm, pn; order_map(L, 128, 7, pm, pn);
        u.arow = nullptr; u.lda = 768; u.chain = 0; u.aux = 0; u.r0 = pm * 256;
        if (pn < 3) { u.A = lat + (size_t)pm * 256 * 768; u.B = wuq + (size_t)pn * 256 * 384; u.ldb = 384; u.K = 384; u.kind = K_QRAW; u.c0 = pn * 256; }
        else { u.A = lat + (size_t)pm * 256 * 768 + 384; u.B = wukv + (size_t)(pn - 3) * 256 * 384; u.ldb = 384; u.K = 256; u.kind = K_KVRAW; u.c0 = (pn - 3) * 256; }
        return true;
    }
};
struct SchedF2 { const bf16 *dft, *zf; int G, c;
    __device__ __forceinline__ bool next(int i, GU& u) const {
        const int L = i * G + c; if (L >= 256) return false;
        const int b = L & 7, idx = L >> 3, ty = idx >> 3, pm = (idx >> 1) & 3, pn = idx & 1;
        u.arow = nullptr; u.lda = KF; u.ldb = KF; u.K = KF; u.chain = 0; u.aux = 4 * b + ty; u.kind = K_FNET;
        u.A = dft + ((size_t)ty * 1024 + pm * 256) * KF; u.B = zf + ((size_t)(b * 4 + ty) * 512 + pn * 256) * KF; u.r0 = pm * 256; u.c0 = pn * 256; return true;
    }
};
struct SchedGate { const bf16 *hb, *wg; int L, gr;
    __device__ __forceinline__ bool next(int i, GU& u) const {
        if (i >= 3) return false;
        int pm, pn; order_map(L, 128, 4, pm, pn);
        u.arow = nullptr; u.lda = 512; u.ldb = 512; u.r0 = gr; u.c0 = 0; u.K = 512; u.chain = 0; u.aux = i; u.kind = K_GATE;
        u.A = hb + (size_t)pm * 256 * 512; u.B = wg + ((size_t)i * 1024 + pn * 256) * 512; return true;
    }
};
struct SchedMerge { const bf16 *yas, *zri, *wp; int L, gr;
    __device__ __forceinline__ bool next(int i, GU& u) const {
        if (i >= 3) return false;
        int pm, pn; order_map(L, 128, 4, pm, pn);
        u.arow = nullptr; u.lda = 1024; u.ldb = 1024; u.r0 = gr; u.c0 = 0; u.K = i == 2 ? 1024 : 512; u.chain = i > 0; u.aux = i | (pm << 8) | (pn << 20); u.kind = K_MERGE;
        u.A = (i == 2 ? zri : yas + i * 512) + (size_t)pm * 256 * 1024; u.B = wp + (i == 2 ? (size_t)1024 * 1024 : (size_t)i * 512) + (size_t)pn * 256 * 1024; return true;
    }
};
struct SchedG6 { const bf16 *a, *w; int G, c; int kind, ntn;
    __device__ __forceinline__ bool next(int i, GU& u) const {
        const int L = i * G + c; if (L >= 128 * ntn) return false;
        int pm, pn; order_map(L, 128, ntn, pm, pn);
        u.arow = nullptr; u.lda = 1024; u.ldb = 1024; u.K = 1024; u.chain = 0; u.aux = 0; u.kind = kind;
        u.A = a + (size_t)pm * 256 * 1024; u.B = w + (size_t)pn * 256 * 1024; u.r0 = pm * 256; u.c0 = pn * 256; return true;
    }
};
struct SchedRT { const bf16 *xb, *wr; int G, c;
    __device__ __forceinline__ bool next(int i, GU& u) const {
        const int L = i * G + c; if (L >= 256) return false;
        const int pm = L >> 1, kh = L & 1;
        u.arow = nullptr; u.lda = 1024; u.ldb = 1024; u.K = 512; u.chain = 0; u.aux = kh; u.kind = K_ROUTER;
        u.A = xb + (size_t)pm * 256 * 1024 + kh * 512; u.B = wr + kh * 512; u.r0 = pm * 256; u.c0 = 0; return true;
    }
};
struct SchedM1 { const bf16 *h2, *w13; const int* tos; const LAS int* tb; int G, c;
    __device__ __forceinline__ bool next(int i, GU& u) const {
        const int L = i * G + c; const int nt = __builtin_amdgcn_readfirstlane(tb[32]); if (L >= nt * 2) return false;
        const int rt = L >> 1, pn = L & 1; const int e = __builtin_amdgcn_readfirstlane(tb[64 + rt]);
        u.arow = tos + rt * 256; u.A = h2; u.lda = 1024; u.B = w13 + ((size_t)e * 512 + pn * 256) * 1024; u.ldb = 1024; u.K = 1024; u.chain = 0; u.aux = e; u.kind = K_M1;
        u.r0 = rt * 256; u.c0 = pn * 128; return true;
    }
};
struct SchedM2 { const bf16 *hid, *w2; const LAS int* tb; int G, c;
    __device__ __forceinline__ bool next(int i, GU& u) const {
        const int L = i * G + c; const int nt = __builtin_amdgcn_readfirstlane(tb[32]); if (L >= nt * 4) return false;
        const int rt = L >> 2, pn = L & 3; const int e = __builtin_amdgcn_readfirstlane(tb[64 + rt]);
        u.arow = nullptr; u.A = hid + (size_t)rt * 256 * 256; u.lda = 256; u.B = w2 + ((size_t)e * 1024 + pn * 256) * 256; u.ldb = 256; u.K = 256; u.chain = 0; u.aux = e; u.kind = K_M2;
        u.r0 = rt * 256; u.c0 = pn * 256; return true;
    }
};

template <class F>
__device__ __forceinline__ void cvt_rows(bf16* dst, int nrows, int K, int gtid, int gsz, F src) {
    const int kg = K >> 3; const int total = nrows * kg;
    for (int it = gtid; it < total; it += gsz) {
        const int n = it % nrows, k0 = (it / nrows) * 8;
        u32x4 o; o.x = pk2(src(n, k0), src(n, k0 + 1)); o.y = pk2(src(n, k0 + 2), src(n, k0 + 3)); o.z = pk2(src(n, k0 + 4), src(n, k0 + 5)); o.w = pk2(src(n, k0 + 6), src(n, k0 + 7));
        *(u32x4*)(dst + (size_t)n * K + k0) = o;
    }
}
template <bool F8 = false>
__device__ __forceinline__ void tr_item(const float* src, int ld, const float* gain, bf16* dst, int dld, LAS float* scr, int lane) {
    const int c32 = lane & 31, h = lane >> 5;
    if (src) {
        float v[32];
#pragma unroll
        for (int i = 0; i < 32; ++i) v[i] = src[(size_t)(2 * i + h) * ld + c32];
#pragma unroll
        for (int i = 0; i < 32; ++i) scr[(2 * i + h) * 33 + c32] = v[i];
    } else {
#pragma unroll 8
        for (int i = 0; i < 32; ++i) scr[(2 * i + h) * 33 + c32] = 0.f;
    }
    asm volatile("s_waitcnt lgkmcnt(0)" ::: "memory");
    const int c = lane & 7;
    float g8[8];
#pragma unroll
    for (int q = 0; q < 8; ++q) g8[q] = gain ? gain[8 * c + q] : 1.0f;
#pragma unroll
    for (int j = 0; j < 4; ++j) { const int n = (lane >> 3) + 8 * j; const LAS float* sp = scr + (8 * c) * 33 + n;
        if (F8) { u32x2 o8; o8.x = pk4f8(sp[0 * 33] * GATE_S, sp[1 * 33] * GATE_S, sp[2 * 33] * GATE_S, sp[3 * 33] * GATE_S); o8.y = pk4f8(sp[4 * 33] * GATE_S, sp[5 * 33] * GATE_S, sp[6 * 33] * GATE_S, sp[7 * 33] * GATE_S);
            *(u32x2*)((unsigned char*)dst + (size_t)n * dld + 8 * c) = o8; continue; }
        u32x4 o; o.x = pk2(sp[0 * 33] * g8[0], sp[1 * 33] * g8[1]); o.y = pk2(sp[2 * 33] * g8[2], sp[3 * 33] * g8[3]); o.z = pk2(sp[4 * 33] * g8[4], sp[5 * 33] * g8[5]); o.w = pk2(sp[6 * 33] * g8[6], sp[7 * 33] * g8[7]);
        *(u32x4*)(dst + (size_t)n * dld + 8 * c) = o; }
    asm volatile("s_waitcnt lgkmcnt(0)" ::: "memory");
}
__device__ __forceinline__ void phase_weights(const Ctx& X, LAS unsigned char* lds, const int wv) {
    const int tid = tid_(wv); const int lane = tid & 63, wid = tid >> 6;
    const int gtid = blockIdx.x * blockDim.x + tid, gsz = gridDim.x * blockDim.x, gw = gtid >> 6, ngw = gsz >> 6;
    LAS float* scr = (LAS float*)(lds) + wid * (64 * 33);
    LAS float* wt = (LAS float*)(lds + 69632);
    LAS float* ct128 = (LAS float*)(lds + 86528);
    LAS float* ct4096 = (LAS float*)(lds + 87040);
    const float* w_in = X.inp(3, (size_t)D * NIN);
    if (gtid == 0) { const float* kn = X.inp(9, QKH); float g = 0.f; for (int i = 0; i < QKH; ++i) g = fmaxf(g, fabsf(kn[i])); ((float*)X.misc(M_GMK))[X.l] = 9.797958971f * g; }
    int base = 0;
#define SEG(nitems) for (int it = (((gw - base) % ngw) + ngw) % ngw, _n = (nitems), _once = (base += _n, 0); it < _n; it += ngw)
    SEG(16 * 72) { const int kb = it / 72, nb = it % 72; const int n0 = nb * 32; const int sc = n0 < 672 ? n0 : (n0 < 768 ? -1 : n0 - 768 + C_SGU);
        tr_item(sc < 0 ? nullptr : w_in + (size_t)(kb * 64) * NIN + sc, NIN, nullptr, X.w(W_IN) + (size_t)n0 * 1024 + kb * 64, 1024, scr, lane); }
    SEG(16 * 96) { const int kb = it / 96, nb = it % 96;
        tr_item<true>(w_in + (size_t)(kb * 64) * NIN + C_GATE + nb * 32, NIN, nullptr, (bf16*)((unsigned char*)X.w(W_G) + (size_t)(nb * 32) * 1024 + kb * 64), 1024, scr, lane); }
    { const float* w = X.inp(5, (size_t)QL * 768); const float* g = X.inp(4, QL);
      SEG(6 * 24) { const int kb = it / 24, nb = it % 24; tr_item(w + (size_t)(kb * 64) * 768 + nb * 32, 768, g + kb * 64, X.w(W_UQ) + (size_t)(nb * 32) * 384 + kb * 64, 384, scr, lane); } }
    { const float* w = X.inp(7, (size_t)KVL * 1024); const float* g = X.inp(6, KVL);
      SEG(6 * 32) { const int kb = it / 32, nb = it % 32; tr_item(kb < 4 ? w + (size_t)(kb * 64) * 1024 + nb * 32 : nullptr, 1024, kb < 4 ? g + kb * 64 : nullptr, X.w(W_UKV) + (size_t)(nb * 32) * 384 + kb * 64, 384, scr, lane); } }
    for (int br = 0; br < 2; ++br) { const float* w = X.inp(14 + br, (size_t)512 * 1024);
      SEG(8 * 32) { const int kb = it / 32, nb = it % 32; tr_item(w + (size_t)(kb * 64) * 1024 + nb * 32, 1024, nullptr, X.w(W_P) + (size_t)(nb * 32) * 1024 + br * 512 + kb * 64, 1024, scr, lane); } }
    { const float* w = X.inp(17, (size_t)1024 * 1024);
      SEG(16 * 32) { const int kb = it / 32, nb = it % 32; tr_item(w + (size_t)(kb * 64) * 1024 + nb * 32, 1024, nullptr, X.w(W_O) + (size_t)(nb * 32) * 1024 + kb * 64, 1024, scr, lane); } }
    { const float* w1 = X.inp(23, (size_t)NE * D * DE); const float* w3 = X.inp(24, (size_t)NE * D * DE);
      SEG(32 * 16 * 16) { const int e = it >> 8, kb = (it >> 4) & 15, nb = it & 15; const int r = nb * 32, pn = r >> 8, half = (r >> 7) & 1, i0 = r & 127;
          const float* w = (half ? w3 : w1) + ((size_t)e * D + kb * 64) * DE + pn * 128 + i0;
          tr_item(w, DE, X.inp(18, D) + kb * 64, X.w(W_13) + ((size_t)e * 512 + r) * 1024 + kb * 64, 1024, scr, lane); } }
    { const float* w2 = X.inp(25, (size_t)NE * DE * D);
      SEG(32 * 4 * 32) { const int e = it >> 7, kb = (it >> 5) & 3, nb = it & 31;
          tr_item(w2 + ((size_t)e * DE + kb * 64) * D + nb * 32, D, nullptr, X.w(W_2) + ((size_t)e * 1024 + nb * 32) * 256 + kb * 64, 256, scr, lane); } }
#undef SEG
    { const float* wg = X.inp(19, (size_t)D * NG); const float* wr = X.inp(21, (size_t)D * NE); const float* fg = X.inp(18, D);
      cvt_rows(X.w(W_R), 256, 1024, gtid, gsz, [&](int n, int k) { return n < 4 ? wg[(size_t)k * NG + n] * fg[k] : (n < 36 ? wr[(size_t)k * NE + (n - 4)] * fg[k] : 0.f); }); }
    { const float* w = X.inp(12, (size_t)8 * 128 * 128);
      for (int it = gtid; it < 8 * 128 * 128 / 8; it += gsz) { const float* sp = w + (size_t)it * 8; u32x4 o; o.x = pk2(sp[0], sp[1]); o.y = pk2(sp[2], sp[3]); o.z = pk2(sp[4], sp[5]); o.w = pk2(sp[6], sp[7]); *(u32x4*)(X.w(W_S) + (size_t)it * 8) = o; } }
    for (int i = tid; i < 128; i += 512) ct128[i] = cospif((float)i / 64.0f);
    if (X.l == 0) for (int i = tid; i < 4096; i += 512) ct4096[i] = cospif((float)i / 2048.0f) * 0.015625f;
    { const float* wpf = X.inp(16, (size_t)512 * 1024); LAS float* wt2 = (LAS float*)lds;
      const int widu = __builtin_amdgcn_readfirstlane(wid);
      for (int item = blockIdx.x; item < 256; item += gridDim.x) {
        const int jgh = item & 1, part = (item >> 1) & 1, n0 = ((item >> 2) & 15) * 64, g = item >> 6;
        __syncthreads();
        for (int i = tid; i < 128 * 64; i += 512) { const int jp = i >> 6, n = i & 63; wt2[jp * 65 + n] = wpf[(size_t)(g * 128 + jp) * 1024 + n0 + n]; }
        __syncthreads();
        const int jg = jgh * 8 + widu;
        int ix[8], st[8]; float a[8];
#pragma unroll
        for (int q = 0; q < 8; ++q) { st[q] = (jg * 8 + q) & 127; ix[q] = part ? 96 : 0; a[q] = 0.f; }
#pragma unroll 4
        for (int jp = 0; jp < 128; ++jp) { const float w = wt2[jp * 65 + lane];
#pragma unroll
            for (int q = 0; q < 8; ++q) { a[q] += w * ct128[ix[q]]; ix[q] = (ix[q] + st[q]) & 127; } }
        const float sc = 0.08838834764831845f;
        u32x4 o; o.x = pk2(a[0] * sc, a[1] * sc); o.y = pk2(a[2] * sc, a[3] * sc); o.z = pk2(a[4] * sc, a[5] * sc); o.w = pk2(a[6] * sc, a[7] * sc);
        *(u32x4*)(X.w(W_P) + (size_t)1024 * 1024 + (size_t)(n0 + lane) * 1024 + part * 512 + g * 128 + jg * 8) = o;
      } }
    if (X.l == 0) {
        const int* pos = (const int*)X.in[1]; float* cst = (float*)X.misc(M_CS); float* snt = (float*)X.misc(M_SN);
        for (int it = gtid; it < T * 16; it += gsz) { float sv, cv; sincosf((float)pos[it >> 4] * ROPE_INV[it & 15], &sv, &cv); cst[it] = cv; snt[it] = sv; }
    }
    if (X.l == 0) {
        __syncthreads();
        bf16* dft = (bf16*)(X.ws + WS_DFT);
        for (int it = gtid; it < 4 * 1024 * (KF / 8); it += gsz) {
            const int ty = it / (1024 * (KF / 8)), r = it % (1024 * (KF / 8)), jj = r / (KF / 8), n0 = (r % (KF / 8)) * 8; const int kk = 2 * jj + (ty & 1), sh = (ty >> 1) ? 1024 : 0;
            float v[8];
#pragma unroll
            for (int q = 0; q < 8; ++q) { const int m = n0 + q; v[q] = m <= 1024 ? ct4096[(kk * m + sh) & 4095] : 0.f; }
            u32x4 o; o.x = pk2(v[0], v[1]); o.y = pk2(v[2], v[3]); o.z = pk2(v[4], v[5]); o.w = pk2(v[6], v[7]);
            *(u32x4*)(dft + ((size_t)ty * 1024 + jj) * KF + n0) = o;
        }
    }
    __syncthreads();
}

__device__ __forceinline__ void phase_norm(const Ctx& X, const float* xin, int mode, const float* gain, bf16* hb, unsigned char* hb8, const int wv) {
    constexpr int R = 4;
    const int tid = tid_(wv); const int lane = tid & 63, gw = (blockIdx.x * blockDim.x + tid) >> 6, ngw = (gridDim.x * blockDim.x) >> 6;
    const int* sot = (const int*)X.misc(M_SOT); const bf16* ys = X.act(A_YSLOT);
    const float* src = mode ? (const float*)X.out : xin; const bf16* xbs = X.act(A_XB);
    for (int t0 = gw; t0 < T; t0 += R * ngw) {
        f32x4 v[R][4]; int s0[R], s1[R];
#pragma unroll
        for (int r = 0; r < R; ++r) { const int t = t0 + r * ngw; s0[r] = 0; s1[r] = 0; if (mode == 1 && t < T) { s0[r] = sot[2 * t]; s1[r] = sot[2 * t + 1]; } }
#pragma unroll
        for (int r = 0; r < R; ++r) { const int t = t0 + r * ngw; if (t < T) {
            if (mode == 1) { const u32x2* xr = (const u32x2*)(xbs + (size_t)t * D) + lane;
#pragma unroll
                for (int j = 0; j < 4; ++j) { const u32x2 a = xr[64 * j]; v[r][j] = (f32x4){bf2f(a.x & 0xffffu), bf2f(a.x >> 16), bf2f(a.y & 0xffffu), bf2f(a.y >> 16)}; } }
            else { const f32x4* xr = (const f32x4*)(src + (size_t)t * D) + lane;
#pragma unroll
                for (int j = 0; j < 4; ++j) v[r][j] = xr[64 * j]; } } }
        if (mode == 1) {
            u32x2 ya[R][4], yb[R][4];
#pragma unroll
            for (int r = 0; r < R; ++r) { const int t = t0 + r * ngw; if (t < T) { const u32x2* y0 = (const u32x2*)(ys + (size_t)s0[r] * D) + lane; const u32x2* y1 = (const u32x2*)(ys + (size_t)s1[r] * D) + lane;
#pragma unroll
                for (int j = 0; j < 4; ++j) { ya[r][j] = y0[64 * j]; yb[r][j] = y1[64 * j]; } } }
#pragma unroll
            for (int r = 0; r < R; ++r) { const int t = t0 + r * ngw; if (t < T) {
#pragma unroll
                for (int j = 0; j < 4; ++j) { const u32x2 a = ya[r][j], b = yb[r][j];
                    v[r][j][0] += bf2f(a.x & 0xffffu) + bf2f(b.x & 0xffffu); v[r][j][1] += bf2f(a.x >> 16) + bf2f(b.x >> 16);
                    v[r][j][2] += bf2f(a.y & 0xffffu) + bf2f(b.y & 0xffffu); v[r][j][3] += bf2f(a.y >> 16) + bf2f(b.y >> 16); }
                if (hb) { u32x2* o = (u32x2*)((bf16*)X.out + (size_t)t * D) + lane;
#pragma unroll
                    for (int j = 0; j < 4; ++j) { u32x2 w; w.x = pk2(v[r][j][0], v[r][j][1]); w.y = pk2(v[r][j][2], v[r][j][3]); o[64 * j] = w; } }
                else { f32x4* o = (f32x4*)(X.out + (size_t)t * D) + lane;
#pragma unroll
                    for (int j = 0; j < 4; ++j) o[64 * j] = v[r][j]; } } }
        }
        if (hb) {
#pragma unroll
            for (int r = 0; r < R; ++r) { const int t = t0 + r * ngw; if (t < T) { float ss = 0.f;
#pragma unroll
                for (int j = 0; j < 4; ++j) ss += (v[r][j][0] * v[r][j][0] + v[r][j][1] * v[r][j][1]) + (v[r][j][2] * v[r][j][2] + v[r][j][3] * v[r][j][3]);
                const float rs = 1.0f / sqrtf(wave_sum(ss) * (1.0f / D) + EPS);
                u32x2* o8 = (u32x2*)(hb + (size_t)t * D) + lane; const f32x4* g4 = (const f32x4*)gain + lane;
                unsigned* q8 = (unsigned*)(hb8 + (size_t)t * D) + lane;
#pragma unroll
                for (int j = 0; j < 4; ++j) { const f32x4 g = g4[64 * j]; const float y0 = v[r][j][0] * rs * g[0], y1 = v[r][j][1] * rs * g[1], y2 = v[r][j][2] * rs * g[2], y3 = v[r][j][3] * rs * g[3];
                    u32x2 w; w.x = pk2(y0, y1); w.y = pk2(y2, y3); o8[64 * j] = w; q8[64 * j] = pk4f8(y0, y1, y2, y3); } } }
        }
    }
}

__device__ __forceinline__ void unpack8(const u32x4 r, float* f) {
    f[0] = bf2f(r.x & 0xffffu); f[1] = bf2f(r.x >> 16); f[2] = bf2f(r.y & 0xffffu); f[3] = bf2f(r.y >> 16);
    f[4] = bf2f(r.z & 0xffffu); f[5] = bf2f(r.z >> 16); f[6] = bf2f(r.w & 0xffffu); f[7] = bf2f(r.w >> 16);
}
__device__ __forceinline__ u32x4 pack8(const float* f) { u32x4 o; o.x = pk2(f[0], f[1]); o.y = pk2(f[2], f[3]); o.z = pk2(f[4], f[5]); o.w = pk2(f[6], f[7]); return o; }
__device__ __forceinline__ float ssq8(const u32x4 r) { float f[8]; unpack8(r, f); float s = 0.f;
#pragma unroll
    for (int j = 0; j < 8; ++j) s += f[j] * f[j];
    return s; }
__device__ __forceinline__ void phase_sgu(const Ctx& X, LAS float* stat  , const int wv) {
    typedef float f32x16 __attribute__((ext_vector_type(16)));
    const int tid = tid_(wv); const int lane = tid & 63, wid = __builtin_amdgcn_readfirstlane(tid >> 6), r32 = lane & 31, hi = lane >> 5;
    const bf16* ug = X.act(A_SGU); const bf16* vt = X.act(A_VT); bf16* ysg = X.act(A_YAS) + 512; const bf16* wsb = X.w(W_S);
    const float* lng = X.inp(10, 512); const float* lnb = X.inp(11, 512); const float* bs = X.inp(13, (size_t)8 * 128);
    LAS float* red = stat + 256;
    for (int un = blockIdx.x; un < T / 128; un += gridDim.x) {
        const bf16* vt_ = vt; const bf16* ug_ = ug; bf16* ysg_ = ysg; const bf16* wsb_ = wsb;
        asm volatile("" : "+s"(vt_), "+s"(ug_), "+s"(ysg_), "+s"(wsb_));
        const int b = un >> 5, ck = un & 31, t0 = un * 128; const bf16* vtile = vt_ + (size_t)b * 512 * 4096 + ck * 128;
        const int g = wid;
        u32x4 vraw[8][2];
        { const int chg = lane >> 4, oct = lane & 15; u32x4 sv[16];
          { const unsigned soff = (unsigned)((chg * 4096 + 8 * oct) * 2);
            const char* sb = (const char*)(vtile + (size_t)(wid * 64) * 4096);
#pragma unroll
            for (int i = 0; i < 16; ++i) sv[i] = *(const u32x4*)(sb + (size_t)i * (4 * 4096 * 2) + soff); }
          float s1[8], s2[8];
#pragma unroll
          for (int j = 0; j < 8; ++j) { s1[j] = 0.f; s2[j] = 0.f; }
#pragma unroll
          for (int i = 0; i < 16; ++i) { float f[8]; unpack8(sv[i], f);
#pragma unroll
              for (int j = 0; j < 8; ++j) { s1[j] += f[j]; s2[j] += f[j] * f[j]; } }
          asm volatile("" ::: "memory");
#pragma unroll
          for (int ks = 0; ks < 8; ++ks)
#pragma unroll
              for (int cb = 0; cb < 2; ++cb) vraw[ks][cb] = *(const u32x4*)((const char*)(vtile + (size_t)(g * 64 + cb * 32) * 4096 + ks * 16) + (unsigned)((r32 * 4096 + 8 * hi) * 2));
#pragma unroll
          for (int j = 0; j < 8; ++j) { s1[j] += __shfl_xor(s1[j], 16); s1[j] += __shfl_xor(s1[j], 32); s2[j] += __shfl_xor(s2[j], 16); s2[j] += __shfl_xor(s2[j], 32); }
          __syncthreads();
          if (chg == 0) {
#pragma unroll
              for (int j = 0; j < 8; ++j) { red[((wid * 128) + 8 * oct + j) * 2] = s1[j]; red[((wid * 128) + 8 * oct + j) * 2 + 1] = s2[j]; } } }
        __syncthreads();
        if (tid < 128) { float s1 = 0.f, s2 = 0.f;
#pragma unroll
            for (int pp = 0; pp < 8; ++pp) { s1 += red[(pp * 128 + tid) * 2]; s2 += red[(pp * 128 + tid) * 2 + 1]; }
            const float mu = s1 * (1.0f / 512.0f), var = fmaxf(s2 * (1.0f / 512.0f) - mu * mu, 0.f);
            stat[2 * tid] = mu; stat[2 * tid + 1] = 1.0f / sqrtf(var + EPS); }
        __syncthreads();
        float gam[2], bet[2];
#pragma unroll
        for (int cb = 0; cb < 2; ++cb) { gam[cb] = lng[g * 64 + cb * 32 + r32]; bet[cb] = lnb[g * 64 + cb * 32 + r32]; }
        bf16x8 bfr[8][2];
#pragma unroll
        for (int ks = 0; ks < 8; ++ks) {
            const int q0 = ks * 16 + 8 * hi;
            float mu[8], rs[8];
#pragma unroll
            for (int j = 0; j < 8; ++j) { mu[j] = stat[2 * (q0 + j)]; rs[j] = stat[2 * (q0 + j) + 1]; }
#pragma unroll
            for (int cb = 0; cb < 2; ++cb) { const u32x4 raw = vraw[ks][cb];
                float f[8] = {bf2f(raw.x & 0xffffu), bf2f(raw.x >> 16), bf2f(raw.y & 0xffffu), bf2f(raw.y >> 16), bf2f(raw.z & 0xffffu), bf2f(raw.z >> 16), bf2f(raw.w & 0xffffu), bf2f(raw.w >> 16)};
#pragma unroll
                for (int j = 0; j < 8; ++j) f[j] = (f[j] - mu[j]) * rs[j] * gam[cb] + bet[cb];
                u32x4 w; w.x = pk2(f[0], f[1]); w.y = pk2(f[2], f[3]); w.z = pk2(f[4], f[5]); w.w = pk2(f[6], f[7]);
                bfr[ks][cb] = *reinterpret_cast<bf16x8*>(&w); }
        }
        const unsigned woff = (unsigned)((r32 * 128 + 8 * hi) * 2), uoff = (unsigned)((r32 * 512 + 4 * hi) * 2), yoff = (unsigned)((r32 * 1024 + 4 * hi) * 2);
#pragma unroll
        for (int pb = 0; pb < 4; ++pb) {
            bf16x8 wf[8]; u32x2 uu[2][4];
            const char* wb = (const char*)(wsb_ + ((size_t)g * 128 + pb * 32) * 128); const char* ub = (const char*)(ug_ + (size_t)(t0 + pb * 32) * 512 + g * 64);
#pragma unroll
            for (int ks = 0; ks < 8; ++ks) wf[ks] = *(const bf16x8*)(wb + ks * 32 + woff);
            const float bias = bs[g * 128 + pb * 32 + r32];
#pragma unroll
            for (int cb = 0; cb < 2; ++cb)
#pragma unroll
                for (int k = 0; k < 4; ++k) uu[cb][k] = *(const u32x2*)(ub + (cb * 32 + 8 * k) * 2 + uoff);
            f32x16 acc[2];
#pragma unroll
            for (int cb = 0; cb < 2; ++cb) acc[cb] = f32x16{};
#pragma unroll
            for (int ks = 0; ks < 8; ++ks)
#pragma unroll
                for (int cb = 0; cb < 2; ++cb) acc[cb] = __builtin_amdgcn_mfma_f32_32x32x16_bf16(bfr[ks][cb], wf[ks], acc[cb], 0, 0, 0);
            char* yb = (char*)(ysg_ + (size_t)(t0 + pb * 32) * 1024 + g * 64);
#pragma unroll
            for (int cb = 0; cb < 2; ++cb)
#pragma unroll
                for (int k = 0; k < 4; ++k) { const u32x2 uv = uu[cb][k]; u32x2 o;
                    o.x = pk2(bf2f(uv.x & 0xffffu) * (acc[cb][4 * k] + bias), bf2f(uv.x >> 16) * (acc[cb][4 * k + 1] + bias));
                    o.y = pk2(bf2f(uv.y & 0xffffu) * (acc[cb][4 * k + 2] + bias), bf2f(uv.y >> 16) * (acc[cb][4 * k + 3] + bias));
                    *(u32x2*)(yb + (cb * 32 + 8 * k) * 2 + yoff) = o; }
            asm volatile("" ::: "memory");
        }
    }
    { const int tid = tid_(wv), lane = tid & 63;
      const bf16* zt = X.act(A_ZT); bf16* zri = X.act(A_ZRI); const int gw0 = (blockIdx.x * blockDim.x + tid) >> 6, ngw0 = (gridDim.x * blockDim.x) >> 6;
      for (int it = gw0; it < NB * 512; it += ngw0) { const bf16* zr = zt + (size_t)it * 4096 + lane * 64; float a = 0.f;
#pragma unroll
          for (int k = 0; k < 8; ++k) { float f[8]; unpack8(*(const u32x4*)(zr + 8 * k), f); a += (f[0] - f[1]) + (f[2] - f[3]) + (f[4] - f[5]) + (f[6] - f[7]); }
          a = wave_sum(a);
          if (lane == 0) { const int b = it >> 9, ch = it & 511; bf16* o = zri + ((size_t)b * 4096 + 2048) * 1024 + ch; o[0] = (bf16)f2bf(a * 0.015625f); o[512] = 0; } } }
    { const int tid3 = tid_(wv); const int gt = blockIdx.x * blockDim.x + tid3, gs = gridDim.x * blockDim.x; const bf16* zt = X.act(A_ZT); bf16* zf = X.act(A_ZF);
      for (int it = gt; it < NB * 512 * (KF / 8); it += gs) {
          const int g8 = it % (KF / 8), bc = it / (KF / 8), b = bc >> 9, ch = bc & 511, m0 = g8 * 8; const bf16* zr = zt + (size_t)bc * 4096;
          float ee[8], eo[8], oe[8], oo[8];
#pragma unroll
          for (int j = 0; j < 8; ++j) { ee[j] = 0.f; eo[j] = 0.f; oe[j] = 0.f; oo[j] = 0.f; }
          if (m0 < 1024) { float a[8], d[8], ra[8], rb[8]; unpack8(*(const u32x4*)(zr + m0), a); unpack8(*(const u32x4*)(zr + 2048 + m0), d);
              unpack8(*(const u32x4*)(zr + 4096 - m0 - 8), ra); unpack8(*(const u32x4*)(zr + 2048 - m0 - 8), rb);
              if (m0 == 0) { ee[0] = a[0] + d[0]; eo[0] = a[0] - d[0]; }
              else { const float pa = bf2f(zr[4096 - m0]), pb = bf2f(zr[2048 - m0]); const float e1 = a[0] + pa, e2 = pb + d[0], o1 = a[0] - pa, o2 = pb - d[0];
                  ee[0] = e1 + e2; eo[0] = e1 - e2; oe[0] = o1 - o2; oo[0] = o1 + o2; }
#pragma unroll
              for (int j = 1; j < 8; ++j) { const float e1 = a[j] + ra[8 - j], e2 = rb[8 - j] + d[j], o1 = a[j] - ra[8 - j], o2 = rb[8 - j] - d[j];
                  ee[j] = e1 + e2; eo[j] = e1 - e2; oe[j] = o1 - o2; oo[j] = o1 + o2; } }
          else if (m0 == 1024) { const float a0 = bf2f(zr[1024]), d0 = bf2f(zr[3072]); ee[0] = a0 + d0; oo[0] = a0 - d0; }
          bf16* o = zf + ((size_t)(b * 4) * 512 + ch) * KF + m0;
          *(u32x4*)(o) = pack8(ee); *(u32x4*)(o + (size_t)512 * KF) = pack8(eo); *(u32x4*)(o + (size_t)2 * 512 * KF) = pack8(oe); *(u32x4*)(o + (size_t)3 * 512 * KF) = pack8(oo);
      } }
    const int tid2 = tid_(wv), lane2 = tid2 & 63;
    const int gw = (blockIdx.x * blockDim.x + tid2) >> 6, ngw = (gridDim.x * blockDim.x) >> 6;
    const bf16* lat = X.act(A_LAT); float* rsq = (float*)X.misc(M_RSQ); float* rskv = (float*)X.misc(M_RSKV);
    const int li = lane2 & 15, tg = lane2 >> 4;
    for (int t4 = gw; t4 < T / 4; t4 += ngw) {
        const int t = t4 * 4 + tg; const bf16* r = lat + (size_t)t * 768 + li * 8;
        u32x4 c[5];
#pragma unroll
        for (int k = 0; k < 5; ++k) c[k] = *(const u32x4*)(r + 128 * k);
        float sq = ssq8(c[0]) + ssq8(c[1]) + ssq8(c[2]), sk = ssq8(c[3]) + ssq8(c[4]);
#pragma unroll
        for (int o = 1; o < 16; o <<= 1) { sq += __shfl_xor(sq, o); sk += __shfl_xor(sk, o); }
        if (li == 0) { rsq[t] = 1.0f / sqrtf(sq * (1.0f / 384.0f) + EPS); rskv[t] = 1.0f / sqrtf(sk * (1.0f / 256.0f) + EPS); }
    }
}

__device__ __forceinline__ void rope_store(const bf16* src32, float mul, const float* gain, const float* cs, const float* sn, float post, bf16* dst) {
    float a[16], b[16];
    unpack8(*(const u32x4*)(src32), a); unpack8(*(const u32x4*)(src32 + 8), a + 8); unpack8(*(const u32x4*)(src32 + 16), b); unpack8(*(const u32x4*)(src32 + 24), b + 8);
#pragma unroll
    for (int i = 0; i < 16; ++i) { const float x1 = a[i] * mul * gain[64 + i], x2 = b[i] * mul * gain[80 + i]; a[i] = (x1 * cs[i] - x2 * sn[i]) * post; b[i] = (x1 * sn[i] + x2 * cs[i]) * post; }
    *(u32x4*)(dst + 64) = pack8(a); *(u32x4*)(dst + 72) = pack8(a + 8); *(u32x4*)(dst + 80) = pack8(b); *(u32x4*)(dst + 88) = pack8(b + 8);
}
__device__ __forceinline__ void phase_prep(const Ctx& X, const int wv) {
    const int tid = tid_(wv); const int lane = tid & 63, sub = lane & 7, hd = lane >> 3, q4 = sub & 3, ii = 8 * (q4 & 1);
    const int gw = (blockIdx.x * blockDim.x + tid) >> 6, ngw = (gridDim.x * blockDim.x) >> 6;
    const bf16* kv = X.act(A_KV); bf16* kb = X.act(A_KB); const bf16* lat = X.act(A_LAT);
    const float* kn = X.inp(9, QKH); const float* cst = (const float*)X.misc(M_CS); const float* snt = (const float*)X.misc(M_SN);
    float gn[8], g1[8], g2[8];
#pragma unroll
    for (int j = 0; j < 8; ++j) { gn[j] = kn[8 * sub + j]; g1[j] = kn[64 + ii + j]; g2[j] = kn[80 + ii + j]; }
    constexpr int U = 4;
    for (int t0 = gw; t0 < T; t0 += U * ngw) {
        u32x4 nk[U], ro[U], rq[U]; f32x4 c0[U], c1[U], s0[U], s1[U];
#pragma unroll
        for (int u = 0; u < U; ++u) { const int t = t0 + u * ngw; nk[u] = (u32x4){0u, 0u, 0u, 0u}; ro[u] = nk[u]; rq[u] = nk[u]; c0[u] = (f32x4){0.f, 0.f, 0.f, 0.f}; c1[u] = c0[u]; s0[u] = c0[u]; s1[u] = c0[u];
            if (t < T) { nk[u] = *(const u32x4*)(kv + (size_t)t * 1024 + hd * 128 + 8 * sub);
                if (sub < 4) { const bf16* rp = lat + (size_t)t * 768 + 640; ro[u] = *(const u32x4*)(rp + 8 * q4); rq[u] = *(const u32x4*)(rp + 8 * (q4 ^ 2));
                    const f32x4* cp = (const f32x4*)(cst + (size_t)t * 16 + ii); const f32x4* sp = (const f32x4*)(snt + (size_t)t * 16 + ii); c0[u] = cp[0]; c1[u] = cp[1]; s0[u] = sp[0]; s1[u] = sp[1]; } } }
#pragma unroll
        for (int u = 0; u < U; ++u) { const int t = t0 + u * ngw;
            float ss = ssq8(nk[u]) + (sub < 4 ? ssq8(ro[u]) : 0.f);
            ss += __shfl_xor(ss, 1); ss += __shfl_xor(ss, 2); ss += __shfl_xor(ss, 4);
            const float r2 = 1.0f / sqrtf(ss * (1.0f / 96.0f) + EPS);
            if (t < T) { bf16* ko = kb + (size_t)t * 768 + hd * 96;
                float f[8]; unpack8(nk[u], f);
#pragma unroll
                for (int j = 0; j < 8; ++j) f[j] = f[j] * r2 * gn[j];
                *(u32x4*)(ko + 8 * sub) = pack8(f);
                if (sub < 4) { float a[8], b[8]; unpack8(q4 < 2 ? ro[u] : rq[u], a); unpack8(q4 < 2 ? rq[u] : ro[u], b);
#pragma unroll
                    for (int j = 0; j < 8; ++j) { const float cc = j < 4 ? c0[u][j & 3] : c1[u][j & 3], sn_ = j < 4 ? s0[u][j & 3] : s1[u][j & 3]; const float x1 = a[j] * r2 * g1[j], x2 = b[j] * r2 * g2[j];
                        f[j] = q4 < 2 ? x1 * cc - x2 * sn_ : x1 * sn_ + x2 * cc; }
                    *(u32x4*)(ko + 64 + 8 * q4) = pack8(f); } } }
    }
}

__device__ __forceinline__ void phase_attn_naive(const Ctx& X, const int wv) {
    const int tid = tid_(wv); const int lane = tid & 63, fr = lane & 15, fq = lane >> 4;
    const int gw = (blockIdx.x * blockDim.x + tid) >> 6, ngw = (gridDim.x * blockDim.x) >> 6;
    const bf16* qb = X.act(A_Q); const bf16* kb = X.act(A_KB); const bf16* kv = X.act(A_KV); bf16* ya = X.act(A_YAS);
    for (int un = gw; un < NB * NH * (SEQ / 16); un += ngw) {
        const int qt = un & 255, h = (un >> 8) & 7, b = un >> 11; const int tq = b * SEQ + qt * 16;
        bf16x8 qf[3];
#pragma unroll
        for (int s = 0; s < 3; ++s) qf[s] = *(const bf16x8*)(qb + (size_t)(tq + fr) * 768 + h * 96 + s * 32 + 8 * fq);
        f32x4 o[4]; for (int d = 0; d < 4; ++d) o[d] = (f32x4){0.f, 0.f, 0.f, 0.f};
        float m = -1e30f, l = 0.f;
        for (int k0 = 0; k0 < SEQ; k0 += 32) {
            const int tk = b * SEQ + k0;
            f32x4 s0 = (f32x4){0.f, 0.f, 0.f, 0.f}, s1 = s0;
#pragma unroll
            for (int s = 0; s < 3; ++s) {
                const bf16x8 k0f = *(const bf16x8*)(kb + (size_t)(tk + fr) * 768 + h * 96 + s * 32 + 8 * fq);
                const bf16x8 k1f = *(const bf16x8*)(kb + (size_t)(tk + 16 + fr) * 768 + h * 96 + s * 32 + 8 * fq);
                s0 = __builtin_amdgcn_mfma_f32_16x16x32_bf16(k0f, qf[s], s0, 0, 0, 0);
                s1 = __builtin_amdgcn_mfma_f32_16x16x32_bf16(k1f, qf[s], s1, 0, 0, 0);
            }
            float mx = fmaxf(fmaxf(fmaxf(s0[0], s0[1]), fmaxf(s0[2], s0[3])), fmaxf(fmaxf(s1[0], s1[1]), fmaxf(s1[2], s1[3])));
            mx = fmaxf(mx, __shfl_xor(mx, 16)); mx = fmaxf(mx, __shfl_xor(mx, 32));
            const float mn = fmaxf(m, mx), al = exp2f(m - mn); m = mn;
            float p[8]; float ps = 0.f;
#pragma unroll
            for (int j = 0; j < 4; ++j) { p[j] = exp2f(s0[j] - mn); p[4 + j] = exp2f(s1[j] - mn); ps += p[j] + p[4 + j]; }
            l = l * al + ps;
            bf16x8 pf;
#pragma unroll
            for (int j = 0; j < 8; ++j) pf[j] = (short)f2bf(p[j]);
#pragma unroll
            for (int d = 0; d < 4; ++d) {
                bf16x8 vf;
#pragma unroll
                for (int j = 0; j < 8; ++j) { const int key = tk + (j < 4 ? 4 * fq + j : 16 + 4 * fq + (j - 4)); vf[j] = (short)kv[(size_t)key * 1024 + h * 128 + 64 + d * 16 + fr]; }
                o[d] = o[d] * al;
                o[d] = __builtin_amdgcn_mfma_f32_16x16x32_bf16(vf, pf, o[d], 0, 0, 0);
            }
        }
        l += __shfl_xor(l, 16); l += __shfl_xor(l, 32);
        const float il = 1.0f / l;
#pragma unroll
        for (int d = 0; d < 4; ++d) { u32x2 w; w.x = pk2(o[d][0] * il, o[d][1] * il); w.y = pk2(o[d][2] * il, o[d][3] * il);
            *(u32x2*)(ya + (size_t)(tq + fr) * 1024 + h * 64 + d * 16 + 4 * fq) = w; }
    }
}

namespace at {
typedef float f32x16 __attribute__((ext_vector_type(16)));
typedef short s16x4 __attribute__((ext_vector_type(4)));
constexpr int SHM_V = 64 * 64 * 2, SHM_K = 64 * 256, LDS_NEED = 3 * SHM_V + 3 * SHM_K + 8 * 64 * 4;
constexpr float THR2 = 11.5f;
#define KSWZ(row, colB) ((row) * 256 + ((colB) ^ (((row) & 15) << 4)))
#define SBAR() __builtin_amdgcn_sched_barrier(0)
__device__ __forceinline__ int crow(int r, int hi) { return (r & 3) + 8 * (r >> 2) + 4 * hi; }
__device__ __forceinline__ unsigned cvtpk(float lo, float hi) { unsigned r; asm volatile("v_cvt_pk_bf16_f32 %0, %1, %2" : "=v"(r) : "v"(lo), "v"(hi)); return r; }
__device__ __forceinline__ void decide(f32x16& p0, f32x16& p1, float& m_reg, f32x16& negm, float& alpha) {
    float pmax = p0[0];
#pragma unroll
    for (int r = 1; r < 16; ++r) pmax = fmaxf(pmax, p0[r]);
#pragma unroll
    for (int r = 0; r < 16; ++r) pmax = fmaxf(pmax, p1[r]);
    { auto rr = __builtin_amdgcn_permlane32_swap(__float_as_uint(pmax), __float_as_uint(pmax), false, false); pmax = fmaxf(__uint_as_float(rr[0]), __uint_as_float(rr[1])); }
    alpha = 1.f;
    if (__builtin_expect(!__all(pmax <= THR2), 0)) {
        const float dl = fmaxf(pmax, 0.f); m_reg += dl; alpha = __builtin_amdgcn_exp2f(-dl);
#pragma unroll
        for (int r = 0; r < 16; ++r) { p0[r] -= dl; p1[r] -= dl; negm[r] = -m_reg; }
    }
}
__device__ __forceinline__ void exp8(f32x16& p, int base) {
#pragma unroll
    for (int r = 0; r < 8; ++r) p[base + r] = __builtin_amdgcn_exp2f(p[base + r]);
}
__device__ __forceinline__ void finishSM(f32x16& p0, f32x16& p1, bf16x8& pa0, bf16x8& pa1, bf16x8& pa2, bf16x8& pa3) {
#pragma unroll
    for (int r = 0; r < 16; ++r) p1[r] = __builtin_amdgcn_exp2f(p1[r]);
#define PK4(P, BASE, OUT) do { u32x4 w = {cvtpk(P[BASE + 0], P[BASE + 1]), cvtpk(P[BASE + 2], P[BASE + 3]), cvtpk(P[BASE + 4], P[BASE + 5]), cvtpk(P[BASE + 6], P[BASE + 7])}; OUT = *reinterpret_cast<bf16x8*>(&w); } while (0)
    PK4(p0, 0, pa0); PK4(p0, 8, pa1); PK4(p1, 0, pa2); PK4(p1, 8, pa3);
#undef PK4
}
__device__ __forceinline__ void qkt(f32x16& p0, f32x16& p1, const char* Ks, const bf16x8* qr, const f32x16& negm, int r32, int hi) {
#pragma unroll
    for (int d0 = 0; d0 < 6; ++d0) { const int cb = (d0 * 16 + hi * 8) * 2;
        const bf16x8 b0 = *reinterpret_cast<const bf16x8*>(Ks + KSWZ(r32, cb));
        const bf16x8 b1 = *reinterpret_cast<const bf16x8*>(Ks + KSWZ(32 + r32, cb));
        if (d0 == 0) { p0 = __builtin_amdgcn_mfma_f32_32x32x16_bf16(b0, qr[0], negm, 0, 0, 0); p1 = __builtin_amdgcn_mfma_f32_32x32x16_bf16(b1, qr[0], negm, 0, 0, 0); }
        else { p0 = __builtin_amdgcn_mfma_f32_32x32x16_bf16(b0, qr[d0], p0, 0, 0, 0); p1 = __builtin_amdgcn_mfma_f32_32x32x16_bf16(b1, qr[d0], p1, 0, 0, 0); } }
}
__device__ __forceinline__ int v_st(int k, int c) { const int kk = (k & ~0xC) | ((k & 4) << 1) | ((k & 8) >> 1); return ((kk >> 3) * 2 + (c >> 5)) * 512 + ((kk & 7) * 32 + (c & 31)) * 2; }
__device__ __forceinline__ int v_rd_base(int lane) { return ((lane & 3) << 3) | (((lane >> 2) & 3) << 6) | (((lane >> 4) & 1) << 5) | (((lane >> 5) & 1) << 8); }
constexpr int v_rd_off(int d0, int ks, int half) { return d0 * 512 + ks * 2048 + half * 1024; }
template <int OFF> __device__ __forceinline__ s16x4 tr_read(int vb) { s16x4 r; asm volatile("ds_read_b64_tr_b16 %0, %1 offset:%2" : "=&v"(r) : "v"(vb), "i"(OFF) : "memory"); return r; }
template <int D0> __device__ __forceinline__ void pv_one(f32x16& od, int vb, bf16x8 pa0, bf16x8 pa1, bf16x8 pa2, bf16x8 pa3) {
    const s16x4 l0 = tr_read<v_rd_off(D0, 0, 0)>(vb), h0 = tr_read<v_rd_off(D0, 0, 1)>(vb), l1 = tr_read<v_rd_off(D0, 1, 0)>(vb), h1 = tr_read<v_rd_off(D0, 1, 1)>(vb);
    const s16x4 l2 = tr_read<v_rd_off(D0, 2, 0)>(vb), h2 = tr_read<v_rd_off(D0, 2, 1)>(vb), l3 = tr_read<v_rd_off(D0, 3, 0)>(vb), h3 = tr_read<v_rd_off(D0, 3, 1)>(vb);
    asm volatile("s_waitcnt lgkmcnt(0)" ::: "memory"); SBAR();
#define PK(L, H) (bf16x8){L[0], L[1], L[2], L[3], H[0], H[1], H[2], H[3]}
    od = __builtin_amdgcn_mfma_f32_32x32x16_bf16(pa0, PK(l0, h0), od, 0, 0, 0);
    od = __builtin_amdgcn_mfma_f32_32x32x16_bf16(pa1, PK(l1, h1), od, 0, 0, 0);
    od = __builtin_amdgcn_mfma_f32_32x32x16_bf16(pa2, PK(l2, h2), od, 0, 0, 0);
    od = __builtin_amdgcn_mfma_f32_32x32x16_bf16(pa3, PK(l3, h3), od, 0, 0, 0);
#undef PK
}
__device__ __forceinline__ void psum(f32x16& osum, bf16x8 ones, bf16x8 pa0, bf16x8 pa1, bf16x8 pa2, bf16x8 pa3) {
    osum = __builtin_amdgcn_mfma_f32_32x32x16_bf16(pa0, ones, osum, 0, 0, 0); osum = __builtin_amdgcn_mfma_f32_32x32x16_bf16(pa1, ones, osum, 0, 0, 0);
    osum = __builtin_amdgcn_mfma_f32_32x32x16_bf16(pa2, ones, osum, 0, 0, 0); osum = __builtin_amdgcn_mfma_f32_32x32x16_bf16(pa3, ones, osum, 0, 0, 0);
}
__device__ __forceinline__ void pv_d0(f32x16* o, f32x16& osum, bf16x8 ones, int vb, bf16x8 pa0, bf16x8 pa1, bf16x8 pa2, bf16x8 pa3) { psum(osum, ones, pa0, pa1, pa2, pa3); pv_one<0>(o[0], vb, pa0, pa1, pa2, pa3); pv_one<1>(o[1], vb, pa0, pa1, pa2, pa3); }
__device__ __forceinline__ void pv_exp(f32x16* o, f32x16& osum, bf16x8 ones, int vb, bf16x8 pa0, bf16x8 pa1, bf16x8 pa2, bf16x8 pa3, f32x16& pn) { psum(osum, ones, pa0, pa1, pa2, pa3); pv_one<0>(o[0], vb, pa0, pa1, pa2, pa3); exp8(pn, 0); pv_one<1>(o[1], vb, pa0, pa1, pa2, pa3); exp8(pn, 8); }

__device__ __forceinline__ void unit(const bf16* __restrict__ Qb, const bf16* __restrict__ Kh, const bf16* __restrict__ Vh, bf16* __restrict__ Ob, const float* __restrict__ qn, const float* __restrict__ cst, const float* __restrict__ snt, int tok0, float gmk, char* lds, LAS unsigned char* L3, int tid) {
    const int wid = __builtin_amdgcn_readfirstlane(tid >> 6), lane = tid & 63, r32 = lane & 31, hi = lane >> 5;
    const bf16* Qw = Qb + (unsigned)((wid * 32 + r32) * 768 + hi * 8); bf16* Ow = Ob + (unsigned)(wid * 32 * 1024);
    char* V_lds = lds; char* K_lds = lds + 3 * SHM_V;
    float* ws = (float*)(lds + 3 * SHM_V + 3 * SHM_K) + wid * 64; float* li_l = ws; float* al_l = ws + 32;
    bf16x8 qr[6];
    f32x16 negm = f32x16{}; asm volatile("" : "+v"(negm));
    {
        float qf[6][8]; float ss = 0.f;
#pragma unroll
        for (int d0 = 0; d0 < 6; ++d0) { unpack8(*reinterpret_cast<const u32x4*>(Qw + d0 * 16), qf[d0]);
#pragma unroll
            for (int j = 0; j < 8; ++j) ss += qf[d0][j] * qf[d0][j]; }
        { auto rr = __builtin_amdgcn_permlane32_swap(__float_as_uint(ss), __float_as_uint(ss), false, false); ss = __uint_as_float(rr[0]) + __uint_as_float(rr[1]); }
        const float mul = QSCALE / sqrtf(ss * (1.0f / 96.0f) + EPS);
#pragma unroll
        for (int d0 = 0; d0 < 6; ++d0) { const f32x4 g0 = *(const f32x4*)(qn + d0 * 16 + hi * 8), g1 = *(const f32x4*)(qn + d0 * 16 + hi * 8 + 4);
#pragma unroll
            for (int j = 0; j < 4; ++j) { qf[d0][j] *= mul * g0[j]; qf[d0][4 + j] *= mul * g1[j]; } }
        { const float* cp = cst + (size_t)(tok0 + wid * 32 + r32) * 16 + hi * 8; const float* sp = snt + (size_t)(tok0 + wid * 32 + r32) * 16 + hi * 8;
          const f32x4 c0 = *(const f32x4*)cp, c1 = *(const f32x4*)(cp + 4), s0_ = *(const f32x4*)sp, s1_ = *(const f32x4*)(sp + 4);
#pragma unroll
          for (int j = 0; j < 8; ++j) { const float c = j < 4 ? c0[j & 3] : c1[j & 3], sn_ = j < 4 ? s0_[j & 3] : s1_[j & 3]; const float a = qf[4][j], b = qf[5][j]; qf[4][j] = a * c - b * sn_; qf[5][j] = a * sn_ + b * c; } }
        float q2 = 0.f;
#pragma unroll
        for (int d0 = 0; d0 < 6; ++d0) { const u32x4 w = pack8(qf[d0]); qr[d0] = __builtin_bit_cast(bf16x8, w);
            float qq[8]; unpack8(w, qq);
#pragma unroll
            for (int j = 0; j < 8; ++j) q2 += qq[j] * qq[j]; }
        { auto rr = __builtin_amdgcn_permlane32_swap(__float_as_uint(q2), __float_as_uint(q2), false, false); q2 = __uint_as_float(rr[0]) + __uint_as_float(rr[1]); }
        const float mrow = fminf(sqrtf(q2) * gmk * 1.002f + 0.05f, 100.0f);
#pragma unroll
        for (int r = 0; r < 16; ++r) negm[r] = -mrow;
        asm volatile("" : "+v"(negm));
    }
    f32x16 o[2] = {}, osum = {}; const short one_ = (r32 == 0) ? (short)0x3F80 : (short)0; const bf16x8 ones = (bf16x8){one_, one_, one_, one_, one_, one_, one_, one_};
    const int krow0 = wid * 8 + (lane >> 4), kslot = lane & 15;
    int kc0 = kslot ^ (krow0 & 15), kc1 = kslot ^ ((krow0 + 4) & 15); kc0 = kc0 < 12 ? kc0 : kc0 - 12; kc1 = kc1 < 12 ? kc1 : kc1 - 12;
    const unsigned koff0 = (unsigned)(krow0 * 768 + kc0 * 8) * 2u, koff1 = (unsigned)((krow0 + 4) * 768 + kc1 * 8) * 2u;
    const int vkey = wid * 8 + ((lane & 31) >> 2);
    const unsigned voff = (unsigned)(vkey * 1024 + (lane >> 5) * 32 + (lane & 3) * 8) * 2u;
    const int vb0 = (int)(uintptr_t)V_lds + v_rd_base(lane);
#define DMA(slot, t) do { const char* kt = (const char*)Kh + (size_t)(t) * (64 * 768 * 2); const char* vt = (const char*)Vh + (size_t)(t) * (64 * 1024 * 2); \
    __builtin_amdgcn_global_load_lds((const unsigned*)(kt + koff0), (LAS unsigned*)(L3 + 3 * SHM_V + (slot) * SHM_K + wid * 2048), 16, 0, 0); \
    __builtin_amdgcn_global_load_lds((const unsigned*)(kt + koff1), (LAS unsigned*)(L3 + 3 * SHM_V + (slot) * SHM_K + wid * 2048 + 1024), 16, 0, 0); \
    __builtin_amdgcn_global_load_lds((const unsigned*)(vt + voff), (LAS unsigned*)(L3 + (slot) * SHM_V + wid * 1024), 16, 0, 0); } while (0)
#define DMA_WAIT_BAR() do { asm volatile("s_waitcnt vmcnt(0)" ::: "memory"); __syncthreads(); } while (0)
#define RESC(a) do { if (__any((a) < 1.f)) { if (hi == 0) al_l[r32] = (a); asm volatile("s_waitcnt lgkmcnt(0)" ::: "memory"); \
    _Pragma("unroll") for (int d = 0; d < 2; ++d) _Pragma("unroll") for (int r = 0; r < 16; ++r) o[d][r] *= al_l[crow(r, hi)]; } } while (0)
#define NXT(x) ((x) == 2 ? 0 : (x) + 1)
    f32x16 pA0, pA1, pB0, pB1; bf16x8 pa0, pa1, pa2, pa3; constexpr int NT = SEQ / 64;
    DMA(0, 0); DMA(1, 1); DMA_WAIT_BAR();
    qkt(pA0, pA1, K_lds, qr, negm, r32, hi); exp8(pA0, 0); exp8(pA0, 8);
    int s0 = 0;
    for (int t = 0; t + 2 < NT; t += 2) {
        const int s1 = NXT(s0), s2 = NXT(s1);
        DMA(s2, t + 2);
        SBAR(); qkt(pB0, pB1, K_lds + s1 * SHM_K, qr, negm, r32, hi);
        finishSM(pA0, pA1, pa0, pa1, pa2, pa3); SBAR();
        pv_exp(o, osum, ones, vb0 + s0 * SHM_V, pa0, pa1, pa2, pa3, pB0);
        DMA_WAIT_BAR();
        DMA(s0, t + 3);
        SBAR(); qkt(pA0, pA1, K_lds + s2 * SHM_K, qr, negm, r32, hi);
        finishSM(pB0, pB1, pa0, pa1, pa2, pa3); SBAR();
        pv_exp(o, osum, ones, vb0 + s1 * SHM_V, pa0, pa1, pa2, pa3, pA0);
        DMA_WAIT_BAR();
        s0 = s2;
    }
    {
        const int s1 = NXT(s0);
        SBAR(); qkt(pB0, pB1, K_lds + s1 * SHM_K, qr, negm, r32, hi);
        finishSM(pA0, pA1, pa0, pa1, pa2, pa3); SBAR();
        pv_exp(o, osum, ones, vb0 + s0 * SHM_V, pa0, pa1, pa2, pa3, pB0);
        finishSM(pB0, pB1, pa0, pa1, pa2, pa3); SBAR();
        pv_d0(o, osum, ones, vb0 + s1 * SHM_V, pa0, pa1, pa2, pa3);
    }
#undef NXT
#undef DMA
#undef DMA_WAIT_BAR
    if (r32 == 0) {
#pragma unroll
        for (int r = 0; r < 16; ++r) li_l[crow(r, hi)] = osum[r]; }
    asm volatile("s_waitcnt lgkmcnt(0)" ::: "memory");
    float rli[16];
#pragma unroll
    for (int r = 0; r < 16; ++r) rli[r] = __builtin_amdgcn_rcpf(li_l[crow(r, hi)]);
#pragma unroll
    for (int r = 0; r < 16; ++r) { const int orow = crow(r, hi);
#pragma unroll
        for (int d0 = 0; d0 < 2; ++d0) Ow[(long)orow * 1024 + d0 * 32 + r32] = (bf16)f2bf(o[d0][r] * rli[r]); }
    __syncthreads();
#undef RESC
}
#undef KSWZ
#undef SBAR
}
__device__ __forceinline__ void phase_attn_fast(const Ctx& X, char* lds, LAS unsigned char* L3, const int wv) {
    const int tid = tid_(wv);
    const bf16* qb = X.act(A_Q); const bf16* kb = X.act(A_KB); const bf16* kv = X.act(A_KV); bf16* ya = X.act(A_YAS);
    const int G = gridDim.x, c = blockIdx.x; const int vcu = (G % 8 == 0) ? (c % 8) * (G / 8) + c / 8 : c;
    const float gmk = ((const float*)X.misc(M_GMK))[X.l];
    for (int un = vcu; un < NB * NH * (SEQ / 256); un += G) {
        const int qblk = un & 15, h = (un >> 4) & 7, b = un >> 7; const size_t t0 = (size_t)b * SEQ;
        at::unit(qb + (t0 + qblk * 256) * 768 + h * 96, kb + t0 * 768 + h * 96, kv + t0 * 1024 + h * 128 + 64, ya + (t0 + qblk * 256) * 1024 + h * 64,
                 X.inp(8, QKH), (const float*)X.misc(M_CS), (const float*)X.misc(M_SN), (int)t0 + qblk * 256, gmk, lds, L3, tid_(wv));
    }
}

__device__ __forceinline__ void phase_select(const Ctx& X, LAS unsigned* lc  , const int wv) {
    const int tid = tid_(wv);
    const float* lg = (const float*)X.act(A_LOG); const float* bg = X.inp(20, NG); const float* br = X.inp(22, NE);
    int* sele = (int*)X.misc(M_SELE); float* selw = (float*)X.misc(M_SELW); int* selp = (int*)X.misc(M_SELP);
    unsigned* cnt = X.ctl() + CW_CNT + 64 * X.l;
    const float* ssp = (const float*)X.misc(M_SSP); float* rs2 = (float*)X.misc(M_RS2);
    const int G = gridDim.x, per = (T + G - 1) / G;
    for (int i0 = 0; i0 < per; i0 += 512) {
        __syncthreads();
        if (tid < 32) lc[tid] = 0u;
        __syncthreads();
        const int i = i0 + tid, t = blockIdx.x * per + i; const bool on = (i < per) && (t < T);
        int E0 = 0, E1 = 0; unsigned p0 = 0u, p1 = 0u; float w0 = 0.f, w1 = 0.f;
        if (on) {
            const float* r = lg + (size_t)t * 64;
            float ssq = 0.f;
            { const f32x4* sp = (const f32x4*)(ssp + (size_t)t * 16); const f32x4 a = sp[0], b = sp[1], c4 = sp[2], d = sp[3];
              ssq = ((a[0] + a[1]) + (a[2] + a[3])) + ((b[0] + b[1]) + (b[2] + b[3])) + ((c4[0] + c4[1]) + (c4[2] + c4[3])) + ((d[0] + d[1]) + (d[2] + d[3])); }
            const float rsn = 1.0f / sqrtf(ssq * (1.0f / D) + EPS); rs2[t] = rsn;
            float gl[4]; int gs = 0;
#pragma unroll
            for (int q = 0; q < 4; ++q) gl[q] = (r[q] + r[(size_t)T * 64 + q]) * rsn + bg[q];
#pragma unroll
            for (int q = 1; q < 4; ++q) if (gl[q] > gl[gs]) gs = q;
            float den = 0.f;
#pragma unroll
            for (int q = 0; q < 4; ++q) den += expf(gl[q] - gl[gs]);
            const float gw = 1.0f / den;
            float el[8];
#pragma unroll
            for (int q = 0; q < 8; ++q) el[q] = (r[4 + gs * 8 + q] + r[(size_t)T * 64 + 4 + gs * 8 + q]) * rsn + br[gs * 8 + q];
            int q0 = 0;
#pragma unroll
            for (int q = 1; q < 8; ++q) if (el[q] > el[q0]) q0 = q;
            int q1 = (q0 == 0) ? 1 : 0;
#pragma unroll
            for (int q = 0; q < 8; ++q) if (q != q0 && el[q] > el[q1]) q1 = q;
            const float e1 = expf(el[q1] - el[q0]); w0 = gw / (1.0f + e1); w1 = gw * e1 / (1.0f + e1);
            E0 = gs * 8 + q0; E1 = gs * 8 + q1;
            p0 = __hip_atomic_fetch_add(&lc[E0], 1u, __ATOMIC_RELAXED, __HIP_MEMORY_SCOPE_WORKGROUP); p1 = __hip_atomic_fetch_add(&lc[E1], 1u, __ATOMIC_RELAXED, __HIP_MEMORY_SCOPE_WORKGROUP);
        }
        __syncthreads();
        if (tid < 32) { const unsigned n = lc[tid]; lc[32 + tid] = n ? atomicAdd(&cnt[tid], n) : 0u; }
        __syncthreads();
        if (on) { sele[t] = E0 | (E1 << 8); selw[2 * t] = w0; selw[2 * t + 1] = w1; selp[2 * t] = (int)(lc[32 + E0] + p0); selp[2 * t + 1] = (int)(lc[32 + E1] + p1); }
    }
}
__device__ __forceinline__ void moe_table(const Ctx& X, LAS int* tb, const int wv) {
    __syncthreads();
    if (tid_(wv) == 0) { const unsigned* cnt = X.ctl() + CW_CNT + 64 * X.l; int a = 0;
#pragma nounroll
        for (int e = 0; e < 32; ++e) { tb[e] = a; const int n = (int)((__hip_atomic_load(&cnt[e], __ATOMIC_RELAXED, __HIP_MEMORY_SCOPE_AGENT) + 255u) >> 8); for (int j = 0; j < n; ++j) tb[64 + a + j] = e; a += n; } tb[32] = a; }
    __syncthreads();
}
__device__ __forceinline__ void phase_fill(const Ctx& X, LAS int* tb, const int wv) {
    moe_table(X, tb, wv);
    const int tid = tid_(wv); const int gtid = blockIdx.x * blockDim.x + tid, gsz = gridDim.x * blockDim.x;
    const int* sele = (const int*)X.misc(M_SELE); const float* selw = (const float*)X.misc(M_SELW); const int* selp = (const int*)X.misc(M_SELP);
    int* sot = (int*)X.misc(M_SOT); int* tos = (int*)X.misc(M_TOS); float* wos = (float*)X.misc(M_WOS); float* rss = (float*)X.misc(M_RSS); const float* rs2 = (const float*)X.misc(M_RS2);
    const unsigned* cnt = X.ctl() + CW_CNT + 64 * X.l;
    for (int t = gtid; t < T; t += gsz) {
        const int ee = sele[t]; const float rsn = rs2[t];
#pragma unroll
        for (int k = 0; k < 2; ++k) { const int e = (ee >> (8 * k)) & 255; const int slot = tb[e] * 256 + selp[2 * t + k]; sot[2 * t + k] = slot; tos[slot] = t; wos[slot] = selw[2 * t + k]; rss[slot] = rsn; }
    }
    for (int it = gtid; it < 32 * 256; it += gsz) { const int e = it >> 8, j = it & 255; const int c = (int)cnt[e]; const int padn = ((c + 255) & ~255) - c;
        if (j < padn) { const int slot = tb[e] * 256 + c + j; tos[slot] = 0; wos[slot] = 0.f; rss[slot] = 0.f; } }
}

constexpr int NPH = 16;
constexpr int LDS_BYTES = 147456;
constexpr int LDS_MISC = 131072;

__global__ void __launch_bounds__(512, 2) mega(Params p) {
    extern __shared__ __attribute__((aligned(16))) unsigned char lds[];
    LAS unsigned char* L = (LAS unsigned char*)lds;
    volatile LAS unsigned* MISC = (volatile LAS unsigned*)(L + LDS_MISC);
    LAS int* tb = (LAS int*)(L + LDS_MISC + 64);
    LAS float* scr = (LAS float*)(L + LDS_MISC + 2048);
    const int wv = __builtin_amdgcn_readfirstlane(threadIdx.x >> 6);
    if (threadIdx.x < 4) MISC[threadIdx.x] = 0u;
    __syncthreads();
    XcdBarrier bar; bar.bar = (unsigned*)(p.ws + WS_CTL) + CW_BAR; bar.x = 0; bar.st = MISC;
    if (!MK_MULTI) bar = xcd_barrier_post(bar.bar, MISC, wv);
    Ctx X; for (int i = 0; i < 26; ++i) X.in[i] = p.in[i]; X.out = p.out; X.ws = p.ws; X.l = 0;
    const int G = gridDim.x, c = blockIdx.x;
#ifndef PH_MASK
#define PH_MASK 0x1ffffu
#endif
#define IN(g) (((PH_MASK >> ((g) % NPH + ((g) == NPH * NL ? NPH : 0))) & 1u) && p.gp_lo <= (g) && (g) < p.gp_hi)
#ifndef FAST_MASK
#define FAST_MASK 0xffffu
#endif
#ifndef REPEAT_MASK
#define REPEAT_MASK 0u
#endif
#define REP(ph) for (int rep_ = 0; rep_ < (((REPEAT_MASK >> (ph)) & 1u) ? 2 : 1); ++rep_)
#define GEMM(ph, KM, S) do { REP(ph) { if ((FAST_MASK >> (ph)) & 1u) gemm_fast<KM, (ph) == 14>(L, S, E, wv); else gemm_naive<KM>(S, E, wv); } } while (0)
#define SEAM(g) do { if (!MK_MULTI && IN((g) + 1)) xcd_barrier(bar, wv); } while (0)
#define DO_LAYER(LL) { constexpr int l = (LL); \
        X.l = l; const int g0 = NPH * l; \
        Epi E; E.X.ws = p.ws; E.X.out = p.out; E.xres = p.in[0]; E.xresb = (l == 0) ? nullptr : (const bf16*)p.out; \
        if (IN(g0 + 0)) { \
            REP(0) phase_weights(X, L, wv); \
            phase_norm(X, p.in[0], l > 0, X.inp(2, D), X.act(A_HB), (unsigned char*)p.out + HB8_OFF, wv); \
            SEAM(g0 + 0); \
        } \
        if (IN(g0 + 1)) { SchedG1A S{X.act(A_HB), X.w(W_IN), G, c}; GEMM(1, ((1u << K_LAT) | (1u << K_SGU) | (1u << K_ZT) | (1u << K_VT)), S); SEAM(g0 + 1); } \
        if (IN(g0 + 2)) { REP(2) phase_sgu(X, scr, wv); SEAM(g0 + 2); } \
        if (IN(g0 + 3)) { SchedF2 S{(const bf16*)(p.ws + WS_DFT), X.act(A_ZF), G, c}; GEMM(3, ((1u << K_FNET)), S); SEAM(g0 + 3); } \
        if (IN(g0 + 4)) { SchedG34 S{X.act(A_LAT), X.w(W_UQ), X.w(W_UKV), G, c}; GEMM(4, ((1u << K_QRAW) | (1u << K_KVRAW)), S); SEAM(g0 + 4); } \
        if (IN(g0 + 5)) { phase_prep(X, wv); SEAM(g0 + 5); } \
        if (IN(g0 + 6)) { REP(6) { if ((FAST_MASK >> 6) & 1u) phase_attn_fast(X, (char*)lds, L, wv); else phase_attn_naive(X, wv); } SEAM(g0 + 6); } \
        if (IN(g0 + 8)) { for (int tl = c; tl < 512; tl += G) { int gr = c * 256; asm volatile("" : "+s"(gr)); SchedGate S1{(const bf16*)((const unsigned char*)p.out + HB8_OFF), X.w(W_G), tl, gr}; GEMM(8, ((1u << K_GATE)), S1); SchedMerge S2{X.act(A_YAS), X.act(A_ZRI), X.w(W_P), tl, gr}; GEMM(8, ((1u << K_MERGE)), S2); } SEAM(g0 + 8); } \
        if (IN(g0 + 9)) { SchedG6 S{X.act(A_MERGED), X.w(W_O), G, c, K_OUT, 4}; GEMM(9, ((1u << K_OUT)), S); SEAM(g0 + 9); } \
        if (IN(g0 + 11)) { SchedRT S{X.act(A_XB), X.w(W_R), G, c}; GEMM(11, ((1u << K_ROUTER)), S); SEAM(g0 + 11); } \
        if (IN(g0 + 12)) { phase_select(X, (LAS unsigned*)scr, wv); SEAM(g0 + 12); } \
        if (IN(g0 + 13)) { phase_fill(X, tb, wv); SEAM(g0 + 13); } \
        if (IN(g0 + 14)) { moe_table(X, tb, wv); SchedM1 S{X.act(A_XB), X.w(W_13), (const int*)X.misc(M_TOS), tb, G, c}; GEMM(14, ((1u << K_M1)), S); SEAM(g0 + 14); } \
        if (IN(g0 + 15)) { moe_table(X, tb, wv); SchedM2 S{X.act(A_HID), X.w(W_2), tb, G, c}; GEMM(15, ((1u << K_M2)), S); SEAM(g0 + 15); } \
    }
    DO_LAYER(0)
    DO_LAYER(1)
#undef DO_LAYER
    if (IN(NPH * NL)) { X.l = NL - 1; phase_norm(X, nullptr, 1, nullptr, nullptr, nullptr, wv); }
#undef IN
#undef SEAM
}

extern "C" void kernel_launch(void* const* d_in, const int* in_sizes, int n_in, void* d_out, int out_size, void* d_ws, size_t ws_size, hipStream_t stream) {
    static int ok = 0, grid = 256;
    if (ok == 0) {
        ok = 1;
        { int dev = 0, cus = 0; if (hipGetDevice(&dev) == hipSuccess && hipDeviceGetAttribute(&cus, hipDeviceAttributeMultiprocessorCount, dev) == hipSuccess && cus > 0) grid = cus; }
        if (n_in != 26 || in_sizes[0] != T * D || out_size != T * D || ws_size < WS_NEED) { fprintf(stderr, "kernel_launch: unexpected shapes (n_in %d, in0 %d, out %d, ws %zu < %zu)\n", n_in, n_in > 0 ? in_sizes[0] : -1, out_size, ws_size, (size_t)WS_NEED); ok = -1; }
        else if (hipFuncSetAttribute((const void*)mega, hipFuncAttributeMaxDynamicSharedMemorySize, LDS_BYTES) != hipSuccess) { fprintf(stderr, "kernel_launch: hipFuncSetAttribute failed\n"); ok = -1; }
    }
    if (ok < 0) return;
    (void)hipMemsetAsync((char*)d_ws + WS_CTL, 0, CTL_BYTES, stream);
    Params p{};
    for (int i = 0; i < 26; ++i) p.in[i] = (const float*)d_in[i];
    p.out = (float*)d_out; p.ws = (unsigned char*)d_ws;
#if MK_MULTI
    for (int g = 0; g <= NPH * NL; ++g) { p.gp_lo = g; p.gp_hi = g + 1; hipLaunchKernelGGL(mega, dim3(grid), dim3(512), LDS_BYTES, stream, p); }
#else
    p.gp_lo = 0; p.gp_hi = NPH * NL + 1; hipLaunchKernelGGL(mega, dim3(grid), dim3(512), LDS_BYTES, stream, p);
#endif
}
```

```cpp
#include <hip/hip_runtime.h>
#include <cstdio>
#include <cstdint>
#include <cmath>

#ifndef MK_MULTI
#define MK_MULTI 0
#endif

#define LAS __attribute__((address_space(3)))
typedef unsigned short bf16;
typedef short bf16x8 __attribute__((ext_vector_type(8)));
typedef float f32x4 __attribute__((ext_vector_type(4)));
typedef unsigned u32x4 __attribute__((ext_vector_type(4)));
typedef unsigned u32x2 __attribute__((ext_vector_type(2)));

constexpr int D = 1024, NB = 8, SEQ = 4096, T = NB * SEQ, NL = 2;
constexpr int NH = 8, QKN = 64, QKR = 32, QKH = 96, VH = 64, QL = 384, KVL = 256;
constexpr int NIN = 5280, C_SGU = 672, C_FN = 1696, C_GATE = 2208;
constexpr int NE = 32, EPG = 8, NG = 4, DE = 256;
constexpr float EPS = 1e-6f;
constexpr int NSLOT = 73728;
__device__ constexpr float ROPE_INV[16] = {1.000000000e+00f, 5.623413324e-01f, 3.162277639e-01f, 1.778279394e-01f, 1.000000015e-01f, 5.623412877e-02f, 3.162277862e-02f, 1.778279431e-02f,
    9.999999776e-03f, 5.623413250e-03f, 3.162277862e-03f, 1.778279431e-03f, 1.000000047e-03f, 5.623413017e-04f, 3.162277862e-04f, 1.778279402e-04f};
constexpr float QSCALE = 0.10206207261596577f * 1.4426950408889634f;

constexpr size_t MiB = 1ull << 20;
constexpr size_t WS_CTL = 0, CTL_BYTES = 128 * 1024;
constexpr int CW_BAR = 4096;
constexpr int CW_CNT = 16384;
constexpr size_t WS_W = 1 * MiB;
constexpr size_t W_IN = 0;
constexpr size_t W_G = W_IN + 2304ull * 1024 * 2;
constexpr size_t W_UQ = W_G + 3072ull * 1024 * 2;
constexpr size_t W_UKV = W_UQ + 768ull * 384 * 2;
constexpr size_t W_P = W_UKV + 1024ull * 384 * 2;
constexpr size_t W_O = W_P + 1024ull * 2048 * 2;
constexpr size_t W_R = W_O + 1024ull * 1024 * 2;
constexpr size_t W_S = W_R + 256ull * 1024 * 2;
constexpr size_t W_13 = W_S + 8ull * 128 * 128 * 2;
constexpr size_t W_2 = W_13 + 32ull * 512 * 1024 * 2;
constexpr size_t W_END = W_2 + 32ull * 1024 * 256 * 2;
static_assert(W_END <= 67 * MiB, "weights region");
constexpr size_t WS_DFT = 68 * MiB;
constexpr size_t WS_ACT = 100 * MiB;
constexpr size_t A_HB = 0 * MiB;
constexpr size_t A_MERGED = 296 * MiB;
constexpr size_t A_XB = 64 * MiB;
constexpr size_t A_YAS = 64 * MiB;
constexpr size_t A_ZRI = 128 * MiB;
constexpr size_t A_HID = 128 * MiB;
constexpr size_t A_LOG = 168 * MiB;
constexpr size_t A_LAT = 192 * MiB;
constexpr size_t A_SGU = 240 * MiB;
constexpr size_t A_VT = 272 * MiB;
constexpr size_t A_ZT = 304 * MiB;
constexpr int KF = 1152;
constexpr size_t A_ZF = 336 * MiB;
constexpr size_t A_Q = 240 * MiB;
constexpr size_t A_KV = 288 * MiB;
constexpr size_t A_KB = 352 * MiB;
constexpr size_t A_GATE = 192 * MiB;
constexpr size_t A_YSLOT = 192 * MiB;
constexpr size_t ACT_END = 400 * MiB;
constexpr size_t HB8_OFF = 64 * MiB;
constexpr size_t WS_MISC = WS_ACT + ACT_END;
constexpr size_t M_RSQ = 0, M_RSKV = M_RSQ + (size_t)T * 4;
constexpr size_t M_SELE = M_RSKV + (size_t)T * 4;
constexpr size_t M_SELW = M_SELE + (size_t)T * 4;
constexpr size_t M_SELP = M_SELW + (size_t)T * 8;
constexpr size_t M_SOT = M_SELP + (size_t)T * 8;
constexpr size_t M_TOS = M_SOT + (size_t)T * 8;
constexpr size_t M_WOS = M_TOS + (size_t)NSLOT * 4;
constexpr size_t M_RSS = M_WOS + (size_t)NSLOT * 4;
constexpr size_t M_SSP = M_RSS + (size_t)NSLOT * 4;
constexpr size_t M_RS2 = M_SSP + (size_t)T * 64;
constexpr size_t M_CS = M_RS2 + (size_t)T * 4;
constexpr size_t M_SN = M_CS + (size_t)T * 64;
constexpr size_t M_GMK = M_SN + (size_t)T * 64;
constexpr size_t M_END = M_GMK + 256;
constexpr size_t WS_NEED = WS_MISC + M_END;
static_assert(WS_NEED <= 512 * MiB, "workspace");

__device__ __forceinline__ int tid_(int wv) { unsigned z = 0u; asm volatile("" : "+v"(z));
    return wv * 64 + (int)__builtin_amdgcn_mbcnt_hi(~0u, __builtin_amdgcn_mbcnt_lo(~0u, z)); }
__device__ __forceinline__ float bf2f(unsigned b) { return __uint_as_float(b << 16); }
__device__ __forceinline__ unsigned pk2(float lo, float hi) { unsigned r; asm("v_cvt_pk_bf16_f32 %0, %1, %2" : "=v"(r) : "v"(lo), "v"(hi)); return r; }
__device__ __forceinline__ unsigned f2bf(float f) { return pk2(f, 0.0f); }
__device__ __forceinline__ float wave_sum(float v) {
#pragma unroll
    for (int o = 1; o < 64; o <<= 1) v += __shfl_xor(v, o);
    return v;
}
__device__ __forceinline__ float gelu_tanh(float x) {
    const float u = 0.7978845608028654f * (x + 0.044715f * x * x * x);
    const float e = __builtin_amdgcn_exp2f(2.8853900817779268f * u);
    return x - x * __builtin_amdgcn_rcpf(e + 1.0f);
}
__device__ __forceinline__ float sigmoidf_(float x) { return __builtin_amdgcn_rcpf(1.0f + __builtin_amdgcn_exp2f(-1.4426950408889634f * x)); }
constexpr float GATE_S = 32.0f;
__device__ __forceinline__ float gate_sig(float x) { return fminf(1.0f + __builtin_amdgcn_exp2f((-1.4426950408889634f / GATE_S) * x), 1e30f); }
__device__ __forceinline__ unsigned pk4f8(float a, float b, float c, float d) { unsigned w = 0u; w = __builtin_amdgcn_cvt_pk_fp8_f32(a, b, w, false); w = __builtin_amdgcn_cvt_pk_fp8_f32(c, d, w, true); return w; }

#define XB_TMO      128
#define XB_XCNT(j)  (256  + 64 * (j))
#define XB_XSUB(j)  (1280 + 64 * (j))
#define XB_XGEN(j)  (2304 + 64 * (j))
#define XB_TOP      3328
#define XB_TOPGEN   3392
#define XCD_BAR_WORDS 3456
#define XB_SPIN_CAP (1u << 18)
__device__ __forceinline__ unsigned xb_ld(unsigned* p)              { return __hip_atomic_load(p, __ATOMIC_RELAXED, __HIP_MEMORY_SCOPE_AGENT); }
__device__ __forceinline__ unsigned xb_add(unsigned* p, unsigned v) { return __hip_atomic_fetch_add(p, v, __ATOMIC_RELAXED, __HIP_MEMORY_SCOPE_AGENT); }
__device__ __forceinline__ unsigned xb_xcc_id() { return (unsigned)__builtin_amdgcn_s_getreg((3 << 11) | 20) & 0xFu; }
#define XB_SPIN(cond, bar) do { unsigned _sp = 0; while (cond) { __builtin_amdgcn_s_sleep(1); \
    if ((++_sp & 255u) == 0u) { if (xb_ld(&(bar)[XB_TMO])) break; if (_sp > XB_SPIN_CAP) { atomicAdd(&(bar)[XB_TMO], 1u); break; } } } } while (0)
struct XcdBarrier { unsigned* bar; unsigned x; volatile LAS unsigned* st; };
__device__ __forceinline__ XcdBarrier xcd_barrier_post(unsigned* bar, volatile LAS unsigned* st, const int wv) {
    XcdBarrier b; b.bar = bar; b.x = xb_xcc_id(); b.st = st;
    if (tid_(wv) == 0) (void)xb_add(&bar[XB_XCNT(b.x)], 1u);
    return b;
}
__device__ __forceinline__ void xcd_barrier_complete(unsigned* bar, unsigned x, unsigned& nloc, unsigned& nx) {
    const unsigned G = gridDim.x * gridDim.y * gridDim.z;
    unsigned sum, cnt, mine, sp = 0u;
    for (;;) {
        sum = 0u; cnt = 0u; mine = 0u;
#pragma unroll
        for (unsigned j = 0; j < 16; ++j) { const unsigned c = xb_ld(&bar[XB_XCNT(j)]); sum += c; cnt += (c > 0u) ? 1u : 0u; mine = (j == x) ? c : mine; }
        if (sum == G) break;
        __builtin_amdgcn_s_sleep(1);
        if ((++sp & 255u) == 0u) { if (xb_ld(&bar[XB_TMO])) break; if (sp > XB_SPIN_CAP) { atomicAdd(&bar[XB_TMO], 1u); break; } }
    }
    nloc = mine > 0u ? mine : 1u; nx = cnt > 0u ? cnt : 1u;
}
__device__ __forceinline__ void xcd_barrier(const XcdBarrier& b, const int wv) {
    asm volatile("s_waitcnt vmcnt(0)" ::: "memory");
    __syncthreads();
    if (tid_(wv) == 0) {
        unsigned* bar = b.bar;
        __builtin_amdgcn_s_waitcnt(0);
        unsigned nloc = b.st[0], nx = b.st[1];
        if (nloc == 0u) { xcd_barrier_complete(bar, b.x, nloc, nx); b.st[0] = nloc; b.st[1] = nx; }
        const unsigned old = xb_add(&bar[XB_XSUB(b.x)], 1u);
        const unsigned gen = old / nloc;
        if (old + 1u == (gen + 1u) * nloc) {
            __builtin_amdgcn_fence(__ATOMIC_RELEASE, "agent");
            asm volatile("s_waitcnt vmcnt(0)" ::: "memory");
            const unsigned og = xb_add(&bar[XB_TOP], 1u);
            const unsigned tg = og / nx;
            if (og + 1u == (tg + 1u) * nx) xb_add(&bar[XB_TOPGEN], 1u);
            else XB_SPIN(xb_ld(&bar[XB_TOPGEN]) == tg, bar);
            __builtin_amdgcn_fence(__ATOMIC_ACQUIRE, "agent");
            asm volatile("s_waitcnt vmcnt(0)" ::: "memory");
        } else {
            XB_SPIN(xb_ld(&bar[XB_TOPGEN]) == gen, bar);
            __builtin_amdgcn_fence(__ATOMIC_ACQUIRE, "agent");
            asm volatile("s_waitcnt vmcnt(0)" ::: "memory");
        }
    }
    __syncthreads();
}

struct Params { const float* in[26]; float* out; unsigned char* ws; int gp_lo, gp_hi; };

struct Ctx {
    const float* in[26]; float* out; unsigned char* ws; int l;
    __device__ __forceinline__ const float* inp(int i, size_t per_layer) const { return in[i] + (size_t)l * per_layer; }
    __device__ __forceinline__ bf16* w(size_t off) const { return (bf16*)(ws + WS_W + off); }
    __device__ __forceinline__ bf16* act(size_t off) const { return (bf16*)(ws + WS_ACT + off); }
    __device__ __forceinline__ unsigned char* misc(size_t off) const { return ws + WS_MISC + off; }
    __device__ __forceinline__ unsigned* ctl() const { return (unsigned*)(ws + WS_CTL); }
};

enum { K_LAT = 0, K_SGU, K_ZT, K_GATE, K_QRAW, K_KVRAW, K_FNET, K_MERGE, K_OUT, K_ROUTER, K_M1, K_M2, K_VT };
struct GU {
    const bf16* A; const bf16* B;
    const int* arow;
    int lda, ldb, K;
    int kind, r0, c0, aux;
    int chain;
};

struct Epi {
    const float* xres; const bf16* xresb;
    struct { unsigned char* ws; float* out;
        __device__ __forceinline__ bf16* act(size_t off) const { return (bf16*)(ws + WS_ACT + off); }
        __device__ __forceinline__ unsigned char* misc(size_t off) const { return ws + WS_MISC + off; } } X;
    __device__ __forceinline__ void st4(bf16* p, f32x4 v) const { u32x2 w; w.x = pk2(v[0], v[1]); w.y = pk2(v[2], v[3]); *(u32x2*)p = w; }
    struct Pre { u32x4 a, b; };
    template <unsigned KM> __device__ __forceinline__ void prefetch(const GU& u, int r, int c, Pre& P) const {
        const int row = u.r0 + r, col = u.c0 + c;
        if ((KM & (1u << K_OUT)) && u.kind == K_OUT) { const size_t o = (size_t)row * 1024 + col;
            if (xresb) { const u32x2 a = *(const u32x2*)(xresb + o), b = *(const u32x2*)(xresb + o + 128); P.a = (u32x4){a.x << 16, a.x & 0xffff0000u, a.y << 16, a.y & 0xffff0000u}; P.b = (u32x4){b.x << 16, b.x & 0xffff0000u, b.y << 16, b.y & 0xffff0000u}; }
            else { P.a = *(const u32x4*)(xres + o); P.b = *(const u32x4*)(xres + o + 128); } }
        if ((KM & ((1u << K_QRAW) | (1u << K_KVRAW))) && (u.kind == K_QRAW || u.kind == K_KVRAW)) P.a.x = __float_as_uint(((const float*)X.misc(u.kind == K_QRAW ? M_RSQ : M_RSKV))[row]);
        if ((KM & (1u << K_M1)) && u.kind == K_M1) { P.a.x = __float_as_uint(((const float*)X.misc(M_WOS))[row]); P.a.y = __float_as_uint(((const float*)X.misc(M_RSS))[row]); }
        if ((KM & (1u << K_MERGE)) && u.kind == K_MERGE) { const bf16* g = X.act(A_GATE) + (size_t)row * 768 + col + (u.aux & 3) * 256; const int nx = (u.aux & 3) < 2 ? 256 : 0;
            const u32x2 gl = *(const u32x2*)(g), gh = *(const u32x2*)(g + 128), nl = *(const u32x2*)(g + nx), nh = *(const u32x2*)(g + nx + 128);
            P.a = (u32x4){gl.x, gl.y, gh.x, gh.y}; P.b = (u32x4){nl.x, nl.y, nh.x, nh.y}; }
    }
    template <unsigned KM> __device__ __forceinline__ void run(const GU& u, int r, int c, f32x4& lo, f32x4& hi, const Pre& P) const {
        const int row = u.r0 + r, col = u.c0 + c;
        switch (u.kind) {
        case K_LAT: if (KM & (1u << K_LAT)) { bf16* p = X.act(A_LAT) + (size_t)row * 768 + col; st4(p, lo); st4(p + 128, hi); } break;
        case K_VT: if (KM & (1u << K_VT)) {
            const int b = col >> 12, pos = col & 4095;
            bf16* p = X.act(A_VT) + ((size_t)(b * 512 + row) * 4096) + pos;
            f32x4 a, b2;
#pragma unroll
            for (int j = 0; j < 4; ++j) { a[j] = gelu_tanh(lo[j]); b2[j] = gelu_tanh(hi[j]); }
            st4(p, a); st4(p + 128, b2); } break;
        case K_SGU: if (KM & (1u << K_SGU)) { bf16* p = X.act(A_SGU) + (size_t)row * 512 + col;
            f32x4 a, b;
#pragma unroll
            for (int j = 0; j < 4; ++j) { a[j] = gelu_tanh(lo[j]); b[j] = gelu_tanh(hi[j]); }
            st4(p, a); st4(p + 128, b); } break;
        case K_ZT: if (KM & (1u << K_ZT)) {
            bf16* p = X.act(A_ZT) + ((size_t)((col >> 12) * 512 + row) * 4096) + (col & 4095); st4(p, lo); st4(p + 128, hi); } break;
        case K_GATE: if (KM & (1u << K_GATE)) {
            bf16* g = X.act(A_GATE) + (size_t)row * 768 + col + u.aux * 256;
            f32x4 a, b;
#pragma unroll
            for (int j = 0; j < 4; ++j) { a[j] = gate_sig(lo[j]); b[j] = gate_sig(hi[j]); }
            st4(g, a); st4(g + 128, b); } break;
        case K_QRAW: if (KM & (1u << K_QRAW)) { bf16* p = X.act(A_Q) + (size_t)row * 768 + col; st4(p, lo); st4(p + 128, hi); } break;
        case K_KVRAW: if (KM & (1u << K_KVRAW)) { bf16* p = X.act(A_KV) + (size_t)row * 1024 + col; st4(p, lo); st4(p + 128, hi); } break;
        case K_FNET: if (KM & (1u << K_FNET)) {
            const int b = u.aux >> 2, part = (u.aux >> 1) & 1, k = 2 * row + (u.aux & 1); bf16* p = X.act(A_ZRI) + ((size_t)b * 4096 + k) * 1024 + part * 512 + col; st4(p, lo); st4(p + 128, hi);
            if (k > 0) { bf16* q = X.act(A_ZRI) + ((size_t)b * 4096 + 4096 - k) * 1024 + part * 512 + col; if (part) { st4(q, -lo); st4(q + 128, -hi); } else { st4(q, lo); st4(q + 128, hi); } } } break;
        case K_MERGE: if (KM & (1u << K_MERGE)) {
            f32x4 cl, ch_, dl, dh;
            cl[0] = bf2f(P.a.x & 0xffffu); cl[1] = bf2f(P.a.x >> 16); cl[2] = bf2f(P.a.y & 0xffffu); cl[3] = bf2f(P.a.y >> 16);
            ch_[0] = bf2f(P.a.z & 0xffffu); ch_[1] = bf2f(P.a.z >> 16); ch_[2] = bf2f(P.a.w & 0xffffu); ch_[3] = bf2f(P.a.w >> 16);
            dl[0] = bf2f(P.b.x & 0xffffu); dl[1] = bf2f(P.b.x >> 16); dl[2] = bf2f(P.b.y & 0xffffu); dl[3] = bf2f(P.b.y >> 16);
            dh[0] = bf2f(P.b.z & 0xffffu); dh[1] = bf2f(P.b.z >> 16); dh[2] = bf2f(P.b.w & 0xffffu); dh[3] = bf2f(P.b.w >> 16);
            if ((u.aux & 3) < 2) {
#pragma unroll
                for (int j = 0; j < 4; ++j) { lo[j] *= dl[j] * __builtin_amdgcn_rcpf(cl[j]); hi[j] *= dh[j] * __builtin_amdgcn_rcpf(ch_[j]); }
            } else { bf16* p = X.act(A_MERGED) + (size_t)(((u.aux >> 8) & 0xfff) * 256 + r) * 1024 + (u.aux >> 20) * 256 + c; f32x4 ol, oh;
#pragma unroll
                for (int j = 0; j < 4; ++j) { ol[j] = lo[j] * __builtin_amdgcn_rcpf(cl[j]); oh[j] = hi[j] * __builtin_amdgcn_rcpf(ch_[j]); }
                st4(p, ol); st4(p + 128, oh); } } break;
        case K_OUT: if (KM & (1u << K_OUT)) { const size_t o = (size_t)row * 1024 + col;
            const f32x4 a = __builtin_bit_cast(f32x4, P.a), b = __builtin_bit_cast(f32x4, P.b);
            *(f32x4*)(X.out + o) = a + lo; *(f32x4*)(X.out + o + 128) = b + hi; } break;
        case K_ROUTER: if (KM & (1u << K_ROUTER)) { if (col < 64) *(f32x4*)((float*)X.act(A_LOG) + (size_t)u.aux * T * 64 + (size_t)row * 64 + col) = lo; } break;
        case K_M1: if (KM & (1u << K_M1)) {
            const float wgt = __uint_as_float(P.a.x), rs = __uint_as_float(P.a.y);
            f32x4 h;
#pragma unroll
            for (int j = 0; j < 4; ++j) { const float a = lo[j] * rs; h[j] = a * sigmoidf_(a) * (hi[j] * rs) * wgt; }
            st4(X.act(A_HID) + (size_t)row * 256 + col, h); } break;
        case K_M2: if (KM & (1u << K_M2)) { bf16* p = X.act(A_YSLOT) + (size_t)row * 1024 + col; st4(p, lo); st4(p + 128, hi); } break;
        }
    }
    __device__ __forceinline__ void st8(bf16* p, f32x4 a, f32x4 b) const { u32x4 w; w.x = pk2(a[0], a[1]); w.y = pk2(a[2], a[3]); w.z = pk2(b[0], b[1]); w.w = pk2(b[2], b[3]); *(u32x4*)p = w; }
    template <unsigned KM> __device__ __forceinline__ void run8(const GU& u, int r, int c, f32x4& lo0, f32x4& lo1, f32x4& hi0, f32x4& hi1, const Pre& P0, const Pre& P1) const {
        const int row = u.r0 + r, col = u.c0 + c; bf16* p = nullptr; int act = 0;
        constexpr unsigned PLAIN = (1u << K_LAT) | (1u << K_SGU) | (1u << K_ZT) | (1u << K_VT) | (1u << K_QRAW) | (1u << K_KVRAW) | (1u << K_FNET) | (1u << K_M2);
        if ((KM & PLAIN) && ((PLAIN >> u.kind) & 1u)) {
            switch (u.kind) {
            case K_LAT: if (KM & (1u << K_LAT)) p = X.act(A_LAT) + (size_t)row * 768 + col; break;
            case K_SGU: if (KM & (1u << K_SGU)) { p = X.act(A_SGU) + (size_t)row * 512 + col; act = 1; } break;
            case K_ZT: if (KM & (1u << K_ZT)) p = X.act(A_ZT) + ((size_t)((col >> 12) * 512 + row) * 4096) + (col & 4095); break;
            case K_VT: if (KM & (1u << K_VT)) { p = X.act(A_VT) + ((size_t)((col >> 12) * 512 + row) * 4096) + (col & 4095); act = 1; } break;
            case K_QRAW: if (KM & (1u << K_QRAW)) { p = X.act(A_Q) + (size_t)row * 768 + col; act = 3; } break;
            case K_KVRAW: if (KM & (1u << K_KVRAW)) { p = X.act(A_KV) + (size_t)row * 1024 + col; act = 4; } break;
            case K_FNET: if (KM & (1u << K_FNET)) p = X.act(A_ZRI) + ((size_t)(u.aux >> 2) * 4096 + 2 * row + (u.aux & 1)) * 1024 + ((u.aux >> 1) & 1) * 512 + col; break;
            case K_M2: if (KM & (1u << K_M2)) p = X.act(A_YSLOT) + (size_t)row * 1024 + col; break;
            }
            f32x4 a0 = lo0, a1 = lo1, b0 = hi0, b1 = hi1;
            if ((KM & ((1u << K_SGU) | (1u << K_VT))) && act == 1) {
#pragma unroll
                for (int j = 0; j < 4; ++j) { a0[j] = gelu_tanh(a0[j]); a1[j] = gelu_tanh(a1[j]); b0[j] = gelu_tanh(b0[j]); b1[j] = gelu_tanh(b1[j]); } }
            if ((KM & ((1u << K_QRAW) | (1u << K_KVRAW))) && act >= 3) { const float rs = __uint_as_float(P0.a.x); a0 *= rs; a1 *= rs; b0 *= rs; b1 *= rs; }
            st8(p, a0, a1); st8(p + 128, b0, b1);
            if ((KM & (1u << K_FNET)) && u.kind == K_FNET && (2 * row + (u.aux & 1)) > 0) {
                bf16* q = X.act(A_ZRI) + ((size_t)(u.aux >> 2) * 4096 + 4096 - (2 * row + (u.aux & 1))) * 1024 + ((u.aux >> 1) & 1) * 512 + col;
                if (u.aux & 2) { a0 = -a0; a1 = -a1; b0 = -b0; b1 = -b1; }
                st8(q, a0, a1); st8(q + 128, b0, b1); }
        } else if ((KM & (1u << K_OUT)) && u.kind == K_OUT) {
            const size_t o = (size_t)row * 1024 + col;
            const f32x4 x0 = __builtin_bit_cast(f32x4, P0.a) + lo0, x1 = __builtin_bit_cast(f32x4, P1.a) + lo1, y0 = __builtin_bit_cast(f32x4, P0.b) + hi0, y1 = __builtin_bit_cast(f32x4, P1.b) + hi1;
            bf16* xb = X.act(A_XB) + o; st8(xb, x0, x1); st8(xb + 128, y0, y1);
            float ss = 0.f;
#pragma unroll
            for (int j = 0; j < 4; ++j) ss += x0[j] * x0[j] + x1[j] * x1[j] + y0[j] * y0[j] + y1[j] * y1[j];
            ss += __shfl_xor(ss, 16); ss += __shfl_xor(ss, 32);
            if ((c & 24) == 0) ((float*)X.misc(M_SSP))[(size_t)row * 16 + (u.c0 >> 8) * 4 + (c >> 5)] = ss;
        } else if ((KM & (1u << K_GATE)) && u.kind == K_GATE) {
            f32x4 a0, a1, b0, b1;
#pragma unroll
            for (int j = 0; j < 4; ++j) { a0[j] = gate_sig(lo0[j]); a1[j] = gate_sig(lo1[j]); b0[j] = gate_sig(hi0[j]); b1[j] = gate_sig(hi1[j]); }
            bf16* g = X.act(A_GATE) + (size_t)row * 768 + col + u.aux * 256;
            st8(g, a0, a1); st8(g + 128, b0, b1);
        } else { run<KM>(u, r, c, lo0, hi0, P0); run<KM>(u, r, c + 4, lo1, hi1, P1); }
    }
};

template <unsigned KM, class Sched>
__device__ __forceinline__ void gemm_naive(const Sched& S, const Epi& E, const int wv) {
    const int tid = tid_(wv); const int lane = tid & 63, wid = tid >> 6, fr = lane & 15, fq = lane >> 4;
    f32x4 acc[2][16];
    GU u;
    for (int i = 0; S.next(i, u); ++i) {
        if (!u.chain) {
#pragma unroll
            for (int mi = 0; mi < 2; ++mi)
#pragma unroll
                for (int ni = 0; ni < 16; ++ni) acc[mi][ni] = (f32x4){0.f, 0.f, 0.f, 0.f};
        }
        const bf16* ap[2];
#pragma unroll
        for (int mi = 0; mi < 2; ++mi) { const int r = 32 * wid + 16 * mi + fr; const size_t rr = u.arow ? (size_t)u.arow[r] : (size_t)r; ap[mi] = u.A + rr * u.lda + 8 * fq; }
        const bf16* bp = u.B + (size_t)fr * u.ldb + 8 * fq;
        for (int k0 = 0; k0 < u.K; k0 += 32) {
            const bf16x8 a0 = *(const bf16x8*)(ap[0] + k0), a1 = *(const bf16x8*)(ap[1] + k0);
#pragma unroll
            for (int ni = 0; ni < 16; ++ni) {
                const bf16x8 b = *(const bf16x8*)(bp + (size_t)(16 * ni) * u.ldb + k0);
                acc[0][ni] = __builtin_amdgcn_mfma_f32_16x16x32_bf16(b, a0, acc[0][ni], 0, 0, 0);
                acc[1][ni] = __builtin_amdgcn_mfma_f32_16x16x32_bf16(b, a1, acc[1][ni], 0, 0, 0);
            }
        }
#pragma unroll
        for (int mi = 0; mi < 2; ++mi)
#pragma unroll
            for (int ni = 0; ni < 8; ++ni) { Epi::Pre P; E.template prefetch<KM>(u, 32 * wid + 16 * mi + fr, 16 * ni + 4 * fq, P); E.template run<KM>(u, 32 * wid + 16 * mi + fr, 16 * ni + 4 * fq, acc[mi][ni], acc[mi][ni + 8], P); }
    }
}

constexpr int BK = 64, HTB = 128 * BK * 2;
__host__ __device__ __forceinline__ int lds_byte(int r, int c) { const int st = (r >> 4) * 2 + (c >> 5), rr = r & 15, cc = c & 31, ob = rr * 64 + cc * 2; return st * 1024 + (ob ^ (((ob >> 9) & 1) << 5)); }
__host__ __device__ __forceinline__ void stage_rc(int b, int& R, int& C) { const int st = b / 1024, sb = b % 1024, swz = sb ^ (((sb >> 9) & 1) << 5); R = (st >> 1) * 16 + swz / 64; C = (st & 1) * 32 + (swz % 64) / 2; }
__host__ __device__ __forceinline__ int perm32(int rho) { const int n = rho >> 4, i = rho & 15; return 8 * (i >> 2) + 4 * n + (i & 3); }
struct StageOff { unsigned a[2][2], b[2]; };
__device__ __forceinline__ void stage_offsets(const GU& u, const int (&R)[2], const int (&C)[2], const int (&Rb)[2], StageOff& o) {
#pragma unroll
    for (int i = 0; i < 2; ++i) {
        o.b[i] = (unsigned)(Rb[i] * u.ldb + C[i]) * 2u;
#pragma unroll
        for (int h = 0; h < 2; ++h) { const int row = R[i] + 128 * h; const int sr = u.arow ? u.arow[row] : row; o.a[h][i] = (unsigned)(sr * u.lda + C[i]) * 2u; }
    }
}
template <unsigned KM, bool VAR, class Sched>
__device__ __forceinline__ void gemm_fast(LAS unsigned char* lds, const Sched& S, const Epi& E, const int wv) {
    const int tid = tid_(wv); const int wid = __builtin_amdgcn_readfirstlane(tid >> 6), lane = tid & 63, wr = wid >> 2, wc = wid & 3, fr = lane & 15, fq = lane >> 4;
    int R[2], C[2], Rb[2];
#pragma unroll
    for (int i = 0; i < 2; ++i) { stage_rc(tid * 16 + i * 8192, R[i], C[i]); Rb[i] = (R[i] & ~31) + perm32(R[i] & 31); }
    const size_t kstep = (size_t)(BK * 2);
    const unsigned ldsw = (unsigned)wid * 1024u;
    const int aoff = lds_byte(wr * 64 + fr, fq * 8), boff = lds_byte(wc * 32 + fr, fq * 8);
#define PG8_SA(b, h) (((b) * 2 + (h)) * HTB)
#define PG8_SB(b, h) ((4 + (b) * 2 + (h)) * HTB)
#define PG8_STAGE2(bufoff, gbase, v0, v1) do { \
        __builtin_amdgcn_global_load_lds((const unsigned*)((const char*)(gbase) + (v0)), (LAS unsigned*)(lds + (bufoff) + ldsw), 16, 0, 0); \
        __builtin_amdgcn_global_load_lds((const unsigned*)((const char*)(gbase) + (v1)), (LAS unsigned*)(lds + (bufoff) + ldsw + 8192), 16, 0, 0); } while (0)
#define PG8_LDA(dst, b, h) do { _Pragma("unroll") for (int m = 0; m < 4; ++m) _Pragma("unroll") for (int k = 0; k < 2; ++k) dst[m][k] = *(const LAS bf16x8*)(lds + PG8_SA(b, h) + aoff + m * 2048 + k * 1024); } while (0)
#define PG8_LDB(dst, b, h) do { _Pragma("unroll") for (int n = 0; n < 2; ++n) _Pragma("unroll") for (int k = 0; k < 2; ++k) dst[n][k] = *(const LAS bf16x8*)(lds + PG8_SB(b, h) + boff + n * 2048 + k * 1024); } while (0)
#define PG8_MMA(ai, bj, At, Bt) do { __builtin_amdgcn_s_setprio(1); _Pragma("unroll") for (int m = 0; m < 4; ++m) _Pragma("unroll") for (int n = 0; n < 2; ++n) _Pragma("unroll") for (int k = 0; k < 2; ++k) \
        acc[ai][bj][m][n] = __builtin_amdgcn_mfma_f32_16x16x32_bf16(Bt[n][k], At[m][k], acc[ai][bj][m][n], 0, 0, 0); __builtin_amdgcn_s_setprio(0); } while (0)
    typedef int i32x4_ __attribute__((ext_vector_type(4))); typedef int i32x8_ __attribute__((ext_vector_type(8)));
    constexpr bool F8 = (KM == (1u << K_GATE));
#define PG8_CAT(X0, X1) __builtin_shufflevector(__builtin_bit_cast(i32x4_, X0), __builtin_bit_cast(i32x4_, X1), 0, 1, 2, 3, 4, 5, 6, 7)
#define PG8_MMA8(ai, bj, At, Bt) do { __builtin_amdgcn_s_setprio(1); _Pragma("unroll") for (int m = 0; m < 4; ++m) _Pragma("unroll") for (int n = 0; n < 2; ++n) \
        { const i32x8_ b8_ = PG8_CAT(Bt[n][0], Bt[n][1]), a8_ = PG8_CAT(At[m][0], At[m][1]); asm volatile("v_mfma_f32_16x16x128_f8f6f4 %0, %1, %2, %0" : "+v"(acc[ai][bj][m][n]) : "v"(b8_), "v"(a8_)); }      \
        __builtin_amdgcn_s_setprio(0); } while (0)
#define PG8_MM(ai, bj, At, Bt) do { if (F8) PG8_MMA8(ai, bj, At, Bt); else PG8_MMA(ai, bj, At, Bt); } while (0)
#define PG8_WAIT_V(n) asm volatile("s_waitcnt vmcnt(" #n ")" ::: "memory")
#define PG8_WAIT_L(n) asm volatile("s_waitcnt lgkmcnt(" #n ")" ::: "memory")
#define PG8_BAR __builtin_amdgcn_s_barrier()
#define PG8_SCHED __builtin_amdgcn_sched_barrier(0)
    GU cur, nxt; int ui = 0;
    if (!S.next(0, cur)) return;
    StageOff co, no;
    stage_offsets(cur, R, C, Rb, co);
    f32x4 acc[2][2][4][2];
#pragma unroll
    for (int a = 0; a < 2; ++a)
#pragma unroll
        for (int b = 0; b < 2; ++b)
#pragma unroll
            for (int m = 0; m < 4; ++m)
#pragma unroll
                for (int n = 0; n < 2; ++n) acc[a][b][m][n] = (f32x4){0.f, 0.f, 0.f, 0.f};
    bf16x8 At[4][2], B0[2][2], B1[2][2];
    const char* cA = (const char*)cur.A; const char* cB = (const char*)cur.B; size_t chB = (size_t)cur.ldb * 256;
    PG8_STAGE2(PG8_SB(0, 0), cB, co.b[0], co.b[1]); PG8_STAGE2(PG8_SB(0, 1), cB + chB, co.b[0], co.b[1]); PG8_STAGE2(PG8_SA(0, 0), cA, co.a[0][0], co.a[0][1]); PG8_STAGE2(PG8_SA(0, 1), cA, co.a[1][0], co.a[1][1]);
    if (wr == 1) PG8_BAR;
    PG8_WAIT_V(2); PG8_BAR;
    PG8_STAGE2(PG8_SB(1, 0), cB + kstep, co.b[0], co.b[1]); PG8_STAGE2(PG8_SA(1, 0), cA + kstep, co.a[0][0], co.a[0][1]); PG8_STAGE2(PG8_SB(1, 1), cB + chB + kstep, co.b[0], co.b[1]);
    PG8_WAIT_V(6); PG8_BAR;
    for (;;) {
        const bool has_next = S.next(ui + 1, nxt);
        const char* nA = cA; const char* nB = cB; size_t nhB = chB; if (VAR) no = co;
        if (has_next) { nA = (const char*)nxt.A; nB = (const char*)nxt.B; if (VAR) { nhB = (size_t)nxt.ldb * 256; stage_offsets(nxt, R, C, Rb, no); } }
        const int nt = cur.K / BK;
#pragma nounroll
        for (int t = 0; t < nt; t += 2) {
            const bool last = (t == nt - 2);
            const char* a1 = cA + (size_t)(t + 1) * kstep;
            const char* a2 = last ? nA : cA + (size_t)(t + 2) * kstep; const char* b2 = last ? nB : cB + (size_t)(t + 2) * kstep;
            const char* a3 = a2 + kstep; const char* b3 = b2 + kstep;
            const size_t h2 = (VAR && last) ? nhB : chB;
            const unsigned va00 = (VAR && last) ? no.a[0][0] : co.a[0][0], va01 = (VAR && last) ? no.a[0][1] : co.a[0][1], va10 = (VAR && last) ? no.a[1][0] : co.a[1][0], va11 = (VAR && last) ? no.a[1][1] : co.a[1][1];
            const unsigned vb0 = (VAR && last) ? no.b[0] : co.b[0], vb1 = (VAR && last) ? no.b[1] : co.b[1];
            PG8_LDB(B0, 0, 0); PG8_LDB(B1, 0, 1); PG8_SCHED; PG8_LDA(At, 0, 0); PG8_STAGE2(PG8_SA(1, 1), a1, co.a[1][0], co.a[1][1]);
            PG8_WAIT_V(8); PG8_WAIT_L(0); PG8_BAR; PG8_MM(0, 0, At, B0); PG8_MM(0, 1, At, B1); PG8_BAR; PG8_SCHED;
            PG8_LDA(At, 0, 1); PG8_STAGE2(PG8_SB(0, 0), b2, vb0, vb1); PG8_STAGE2(PG8_SB(0, 1), b2 + h2, vb0, vb1); PG8_STAGE2(PG8_SA(0, 0), a2, va00, va01);
            PG8_WAIT_V(8); PG8_WAIT_L(0); PG8_BAR; PG8_MM(1, 0, At, B0); PG8_MM(1, 1, At, B1); PG8_BAR; PG8_SCHED;
            PG8_LDB(B0, 1, 0); PG8_LDB(B1, 1, 1); PG8_SCHED; PG8_LDA(At, 1, 0); PG8_STAGE2(PG8_SA(0, 1), a2, va10, va11);
            PG8_WAIT_V(8); PG8_WAIT_L(0); PG8_BAR; PG8_MM(0, 0, At, B0); PG8_MM(0, 1, At, B1); PG8_BAR; PG8_SCHED;
            PG8_LDA(At, 1, 1); PG8_STAGE2(PG8_SB(1, 0), b3, vb0, vb1); PG8_STAGE2(PG8_SB(1, 1), b3 + h2, vb0, vb1); PG8_STAGE2(PG8_SA(1, 0), a3, va00, va01);
            PG8_WAIT_V(8); PG8_WAIT_L(0); PG8_BAR; PG8_MM(1, 0, At, B0); PG8_MM(1, 1, At, B1); PG8_BAR; PG8_SCHED;
        }
        if (wr == 0) PG8_BAR;
        if (F8) asm volatile("s_nop 15\n\ts_nop 15" ::: "memory");
#pragma unroll
        for (int ai = 0; ai < 2; ++ai) {
            Epi::Pre P[4][2];
#pragma unroll
            for (int m = 0; m < 4; ++m)
#pragma unroll
                for (int n = 0; n < 2; ++n) E.template prefetch<KM>(cur, 128 * ai + 64 * wr + 16 * m + fr, 32 * wc + 8 * fq + 4 * n, P[m][n]);
            if (KM & ((1u << K_QRAW) | (1u << K_KVRAW) | (1u << K_M1))) {
#pragma unroll
                for (int m = 0; m < 4; ++m) { asm volatile("" : "+v"(P[m][0].a.x), "+v"(P[m][0].a.y)); if (KM & (1u << K_M1)) asm volatile("" : "+v"(P[m][1].a.x), "+v"(P[m][1].a.y)); }
            }
            if (KM & ((1u << K_OUT) | (1u << K_MERGE))) {
#pragma unroll
                for (int m = 0; m < 4; ++m)
#pragma unroll
                    for (int n = 0; n < 2; ++n) asm volatile("" : "+v"(P[m][n].a), "+v"(P[m][n].b));
            }
#pragma unroll
            for (int m = 0; m < 4; ++m) { E.template run8<KM>(cur, 128 * ai + 64 * wr + 16 * m + fr, 32 * wc + 8 * fq, acc[ai][0][m][0], acc[ai][0][m][1], acc[ai][1][m][0], acc[ai][1][m][1], P[m][0], P[m][1]);
                asm volatile("" ::: "memory"); }
        }
        if (!has_next) break;
        if (!nxt.chain) {
#pragma unroll
            for (int a = 0; a < 2; ++a)
#pragma unroll
                for (int b = 0; b < 2; ++b)
#pragma unroll
                    for (int m = 0; m < 4; ++m)
#pragma unroll
                        for (int n = 0; n < 2; ++n) acc[a][b][m][n] = (f32x4){0.f, 0.f, 0.f, 0.f};
        }
        cur = nxt; cA = nA; cB = nB; if (VAR) { chB = nhB; co = no; } ++ui;
        if (wr == 1) PG8_BAR;
    }
    PG8_WAIT_V(0);
    PG8_BAR;
#undef PG8_SA
#undef PG8_SB
#undef PG8_STAGE2
#undef PG8_LDA
#undef PG8_LDB
#undef PG8_MMA
#undef PG8_MMA8
#undef PG8_MM
#undef PG8_CAT
#undef PG8_WAIT_V
#undef PG8_WAIT_L
#undef PG8_BAR
#undef PG8_SCHED
}

__device__ __forceinline__ void order_map(int L, int nM, int nN, int& pm, int& pn) {
    const int nwg = nM * nN; int wgid = L;
    { const int q = nwg / 8, r = nwg % 8, xcd = wgid % 8, off = wgid / 8; wgid = (xcd < r ? xcd * (q + 1) : r * (q + 1) + (xcd - r) * q) + off; }
    const int nig = 8 * nN, gid = wgid / nig, fm = gid * 8, gsz = (nM - fm) < 8 ? (nM - fm) : 8;
    pm = fm + ((wgid % nig) % gsz); pn = (wgid % nig) / gsz;
}
struct SchedG1A {
    const bf16 *hb, *win; int G, c;
    __device__ __forceinline__ bool next(int i, GU& u) const {
        const int L = i * G + c; if (L >= 128 * 9) return false;
        u.arow = nullptr; u.lda = 1024; u.ldb = 1024; u.K = 1024; u.chain = 0; u.aux = 0;
        int pm, j; order_map(L, 128, 9, pm, j);
        if (j < 5) { u.A = hb + (size_t)pm * 256 * 1024; u.B = win + (size_t)j * 256 * 1024; u.r0 = pm * 256;
            if (j < 3) { u.kind = K_LAT; u.c0 = j * 256; } else { u.kind = K_SGU; u.c0 = (j - 3) * 256; } }
        else { u.A = win + (size_t)j * 256 * 1024; u.B = hb + (size_t)pm * 256 * 1024; u.c0 = pm * 256;
            if (j < 7) { u.kind = K_VT; u.r0 = (j - 5) * 256; } else { u.kind = K_ZT; u.r0 = (j - 7) * 256; } }
        return true;
    }
};
struct SchedG34 { const bf16 *lat, *wuq, *wukv; int G, c;
    __device__ __forceinline__ bool next(int i, GU& u) const {
        const int L = i * G + c; if (L >= 128 * 7) return false;
        int pm, pn; order_map(L, 128, 7, pm, pn);
        u.arow = nullptr; u.lda = 768; u.chain = 0; u.aux = 0; u.r0 = pm * 256;
        if (pn < 3) { u.A = lat + (size_t)pm * 256 * 768; u.B = wuq + (size_t)pn * 256 * 384; u.ldb = 384; u.K = 384; u.kind = K_QRAW; u.c0 = pn * 256; }
        else { u.A = lat + (size_t)pm * 256 * 768 + 384; u.B = wukv + (size_t)(pn - 3) * 256 * 384; u.ldb = 384; u.K = 256; u.kind = K_KVRAW; u.c0 = (pn - 3) * 256; }
        return true;
    }
};
struct SchedF2 { const bf16 *dft, *zf; int G, c;
    __device__ __forceinline__ bool next(int i, GU& u) const {
        const int L = i * G + c; if (L >= 256) return false;
        const int b = L & 7, idx = L >> 3, ty = idx >> 3, pm = (idx >> 1) & 3, pn = idx & 1;
        u.arow = nullptr; u.lda = KF; u.ldb = KF; u.K = KF; u.chain = 0; u.aux = 4 * b + ty; u.kind = K_FNET;
        u.A = dft + ((size_t)ty * 1024 + pm * 256) * KF; u.B = zf + ((size_t)(b * 4 + ty) * 512 + pn * 256) * KF; u.r0 = pm * 256; u.c0 = pn * 256; return true;
    }
};
struct SchedGate { const bf16 *hb, *wg; int L, gr;
    __device__ __forceinline__ bool next(int i, GU& u) const {
        if (i >= 3) return false;
        int pm, pn; order_map(L, 128, 4, pm, pn);
        u.arow = nullptr; u.lda = 512; u.ldb = 512; u.r0 = gr; u.c0 = 0; u.K = 512; u.chain = 0; u.aux = i; u.kind = K_GATE;
        u.A = hb + (size_t)pm * 256 * 512; u.B = wg + ((size_t)i * 1024 + pn * 256) * 512; return true;
    }
};
struct SchedMerge { const bf16 *yas, *zri, *wp; int L, gr;
    __device__ __forceinline__ bool next(int i, GU& u) const {
        if (i >= 3) return false;
        int pm, pn; order_map(L, 128, 4, pm, pn);
        u.arow = nullptr; u.lda = 1024; u.ldb = 1024; u.r0 = gr; u.c0 = 0; u.K = i == 2 ? 1024 : 512; u.chain = i > 0; u.aux = i | (pm << 8) | (pn << 20); u.kind = K_MERGE;
        u.A = (i == 2 ? zri : yas + i * 512) + (size_t)pm * 256 * 1024; u.B = wp + (i == 2 ? (size_t)1024 * 1024 : (size_t)i * 512) + (size_t)pn * 256 * 1024; return true;
    }
};
struct SchedG6 { const bf16 *a, *w; int G, c; int kind, ntn;
    __device__ __forceinline__ bool next(int i, GU& u) const {
        const int L = i * G + c; if (L >= 128 * ntn) return false;
        int pm, pn; order_map(L, 128, ntn, pm, pn);
        u.arow = nullptr; u.lda = 1024; u.ldb = 1024; u.K = 1024; u.chain = 0; u.aux = 0; u.kind = kind;
        u.A = a + (size_t)pm * 256 * 1024; u.B = w + (size_t)pn * 256 * 1024; u.r0 = pm * 256; u.c0 = pn * 256; return true;
    }
};
struct SchedRT { const bf16 *xb, *wr; int G, c;
    __device__ __forceinline__ bool next(int i, GU& u) const {
        const int L = i * G + c; if (L >= 256) return false;
        const int pm = L >> 1, kh = L & 1;
        u.arow = nullptr; u.lda = 1024; u.ldb = 1024; u.K = 512; u.chain = 0; u.aux = kh; u.kind = K_ROUTER;
        u.A = xb + (size_t)pm * 256 * 1024 + kh * 512; u.B = wr + kh * 512; u.r0 = pm * 256; u.c0 = 0; return true;
    }
};
struct SchedM1 { const bf16 *h2, *w13; const int* tos; const LAS int* tb; int G, c;
    __device__ __forceinline__ bool next(int i, GU& u) const {
        const int L = i * G + c; const int nt = __builtin_amdgcn_readfirstlane(tb[32]); if (L >= nt * 2) return false;
        const int rt = L >> 1, pn = L & 1; const int e = __builtin_amdgcn_readfirstlane(tb[64 + rt]);
        u.arow = tos + rt * 256; u.A = h2; u.lda = 1024; u.B = w13 + ((size_t)e * 512 + pn * 256) * 1024; u.ldb = 1024; u.K = 1024; u.chain = 0; u.aux = e; u.kind = K_M1;
        u.r0 = rt * 256; u.c0 = pn * 128; return true;
    }
};
struct SchedM2 { const bf16 *hid, *w2; const LAS int* tb; int G, c;
    __device__ __forceinline__ bool next(int i, GU& u) const {
        const int L = i * G + c; const int nt = __builtin_amdgcn_readfirstlane(tb[32]); if (L >= nt * 4) return false;
        const int rt = L >> 2, pn = L & 3; const int e = __builtin_amdgcn_readfirstlane(tb[64 + rt]);
        u.arow = nullptr; u.A = hid + (size_t)rt * 256 * 256; u.lda = 256; u.B = w2 + ((size_t)e * 1024 + pn * 256) * 256; u.ldb = 256; u.K = 256; u.chain = 0; u.aux = e; u.kind = K_M2;
        u.r0 = rt * 256; u.c0 = pn * 256; return true;
    }
};

template <class F>
__device__ __forceinline__ void cvt_rows(bf16* dst, int nrows, int K, int gtid, int gsz, F src) {
    const int kg = K >> 3; const int total = nrows * kg;
    for (int it = gtid; it < total; it += gsz) {
        const int n = it % nrows, k0 = (it / nrows) * 8;
        u32x4 o; o.x = pk2(src(n, k0), src(n, k0 + 1)); o.y = pk2(src(n, k0 + 2), src(n, k0 + 3)); o.z = pk2(src(n, k0 + 4), src(n, k0 + 5)); o.w = pk2(src(n, k0 + 6), src(n, k0 + 7));
        *(u32x4*)(dst + (size_t)n * K + k0) = o;
    }
}
template <bool F8 = false>
__device__ __forceinline__ void tr_item(const float* src, int ld, const float* gain, bf16* dst, int dld, LAS float* scr, int lane) {
    const int c32 = lane & 31, h = lane >> 5;
    if (src) {
        float v[32];
#pragma unroll
        for (int i = 0; i < 32; ++i) v[i] = src[(size_t)(2 * i + h) * ld + c32];
#pragma unroll
        for (int i = 0; i < 32; ++i) scr[(2 * i + h) * 33 + c32] = v[i];
    } else {
#pragma unroll 8
        for (int i = 0; i < 32; ++i) scr[(2 * i + h) * 33 + c32] = 0.f;
    }
    asm volatile("s_waitcnt lgkmcnt(0)" ::: "memory");
    const int c = lane & 7;
    float g8[8];
#pragma unroll
    for (int q = 0; q < 8; ++q) g8[q] = gain ? gain[8 * c + q] : 1.0f;
#pragma unroll
    for (int j = 0; j < 4; ++j) { const int n = (lane >> 3) + 8 * j; const LAS float* sp = scr + (8 * c) * 33 + n;
        if (F8) { u32x2 o8; o8.x = pk4f8(sp[0 * 33] * GATE_S, sp[1 * 33] * GATE_S, sp[2 * 33] * GATE_S, sp[3 * 33] * GATE_S); o8.y = pk4f8(sp[4 * 33] * GATE_S, sp[5 * 33] * GATE_S, sp[6 * 33] * GATE_S, sp[7 * 33] * GATE_S);
            *(u32x2*)((unsigned char*)dst + (size_t)n * dld + 8 * c) = o8; continue; }
        u32x4 o; o.x = pk2(sp[0 * 33] * g8[0], sp[1 * 33] * g8[1]); o.y = pk2(sp[2 * 33] * g8[2], sp[3 * 33] * g8[3]); o.z = pk2(sp[4 * 33] * g8[4], sp[5 * 33] * g8[5]); o.w = pk2(sp[6 * 33] * g8[6], sp[7 * 33] * g8[7]);
        *(u32x4*)(dst + (size_t)n * dld + 8 * c) = o; }
    asm volatile("s_waitcnt lgkmcnt(0)" ::: "memory");
}
__device__ __forceinline__ void phase_weights(const Ctx& X, LAS unsigned char* lds, const int wv) {
    const int tid = tid_(wv); const int lane = tid & 63, wid = tid >> 6;
    const int gtid = blockIdx.x * blockDim.x + tid, gsz = gridDim.x * blockDim.x, gw = gtid >> 6, ngw = gsz >> 6;
    LAS float* scr = (LAS float*)(lds) + wid * (64 * 33);
    LAS float* wt = (LAS float*)(lds + 69632);
    LAS float* ct128 = (LAS float*)(lds + 86528);
    LAS float* ct4096 = (LAS float*)(lds + 87040);
    const float* w_in = X.inp(3, (size_t)D * NIN);
    if (gw == ngw - 1) { const float* kn = X.inp(9, QKH); float g = fmaxf(fabsf(kn[lane]), lane < QKH - 64 ? fabsf(kn[64 + lane]) : 0.f);
#pragma unroll
        for (int o = 1; o < 64; o <<= 1) g = fmaxf(g, __shfl_xor(g, o));
        if (lane == 0) ((float*)X.misc(M_GMK))[X.l] = 9.797958971f * g; }
    int base = 0;
#define SEG(nitems) for (int it = (((gw - base) % ngw) + ngw) % ngw, _n = (nitems), _once = (base += _n, 0); it < _n; it += ngw)
    SEG(16 * 72) { const int kb = it / 72, nb = it % 72; const int n0 = nb * 32; const int sc = n0 < 672 ? n0 : (n0 < 768 ? -1 : n0 - 768 + C_SGU);
        tr_item(sc < 0 ? nullptr : w_in + (size_t)(kb * 64) * NIN + sc, NIN, nullptr, X.w(W_IN) + (size_t)n0 * 1024 + kb * 64, 1024, scr, lane); }
    SEG(16 * 96) { const int kb = it / 96, nb = it % 96;
        tr_item<true>(w_in + (size_t)(kb * 64) * NIN + C_GATE + nb * 32, NIN, nullptr, (bf16*)((unsigned char*)X.w(W_G) + (size_t)(nb * 32) * 1024 + kb * 64), 1024, scr, lane); }
    { const float* w = X.inp(5, (size_t)QL * 768); const float* g = X.inp(4, QL);
      SEG(6 * 24) { const int kb = it / 24, nb = it % 24; tr_item(w + (size_t)(kb * 64) * 768 + nb * 32, 768, g + kb * 64, X.w(W_UQ) + (size_t)(nb * 32) * 384 + kb * 64, 384, scr, lane); } }
    { const float* w = X.inp(7, (size_t)KVL * 1024); const float* g = X.inp(6, KVL);
      SEG(6 * 32) { const int kb = it / 32, nb = it % 32; tr_item(kb < 4 ? w + (size_t)(kb * 64) * 1024 + nb * 32 : nullptr, 1024, kb < 4 ? g + kb * 64 : nullptr, X.w(W_UKV) + (size_t)(nb * 32) * 384 + kb * 64, 384, scr, lane); } }
    for (int br = 0; br < 2; ++br) { const float* w = X.inp(14 + br, (size_t)512 * 1024);
      SEG(8 * 32) { const int kb = it / 32, nb = it % 32; tr_item(w + (size_t)(kb * 64) * 1024 + nb * 32, 1024, nullptr, X.w(W_P) + (size_t)(nb * 32) * 1024 + br * 512 + kb * 64, 1024, scr, lane); } }
    { const float* w = X.inp(17, (size_t)1024 * 1024);
      SEG(16 * 32) { const int kb = it / 32, nb = it % 32; tr_item(w + (size_t)(kb * 64) * 1024 + nb * 32, 1024, nullptr, X.w(W_O) + (size_t)(nb * 32) * 1024 + kb * 64, 1024, scr, lane); } }
    { const float* w1 = X.inp(23, (size_t)NE * D * DE); const float* w3 = X.inp(24, (size_t)NE * D * DE);
      SEG(32 * 16 * 16) { const int e = it >> 8, kb = (it >> 4) & 15, nb = it & 15; const int r = nb * 32, pn = r >> 8, half = (r >> 7) & 1, i0 = r & 127;
          const float* w = (half ? w3 : w1) + ((size_t)e * D + kb * 64) * DE + pn * 128 + i0;
          tr_item(w, DE, X.inp(18, D) + kb * 64, X.w(W_13) + ((size_t)e * 512 + r) * 1024 + kb * 64, 1024, scr, lane); } }
    { const float* w2 = X.inp(25, (size_t)NE * DE * D);
      SEG(32 * 4 * 32) { const int e = it >> 7, kb = (it >> 5) & 3, nb = it & 31;
          tr_item(w2 + ((size_t)e * DE + kb * 64) * D + nb * 32, D, nullptr, X.w(W_2) + ((size_t)e * 1024 + nb * 32) * 256 + kb * 64, 256, scr, lane); } }
#undef SEG
    { const float* wg = X.inp(19, (size_t)D * NG); const float* wr = X.inp(21, (size_t)D * NE); const float* fg = X.inp(18, D);
      cvt_rows(X.w(W_R), 256, 1024, gsz - 1 - gtid, gsz, [&](int n, int k) { return n < 4 ? wg[(size_t)k * NG + n] * fg[k] : (n < 36 ? wr[(size_t)k * NE + (n - 4)] * fg[k] : 0.f); }); }
    { const float* w = X.inp(12, (size_t)8 * 128 * 128);
      for (int it = gsz - 1 - gtid; it < 8 * 128 * 128 / 8; it += gsz) { const float* sp = w + (size_t)it * 8; u32x4 o; o.x = pk2(sp[0], sp[1]); o.y = pk2(sp[2], sp[3]); o.z = pk2(sp[4], sp[5]); o.w = pk2(sp[6], sp[7]); *(u32x4*)(X.w(W_S) + (size_t)it * 8) = o; } }
    for (int i = tid; i < 128; i += 512) ct128[i] = cospif((float)i / 64.0f);
    if (X.l == 0) for (int i = tid; i < 4096; i += 512) ct4096[i] = cospif((float)i / 2048.0f) * 0.015625f;
    { const float* wpf = X.inp(16, (size_t)512 * 1024); const int widu = __builtin_amdgcn_readfirstlane(wid), fr = lane & 15, fq = lane >> 4;
      __syncthreads();
      for (int pi = widu * (int)gridDim.x + (int)blockIdx.x; pi < 256; pi += 8 * (int)gridDim.x) {
        const int g = pi >> 6, n = (pi & 63) * 16 + fr;
        bf16x8 bw[4];
#pragma unroll
        for (int ks = 0; ks < 4; ++ks) { float f[8];
#pragma unroll
            for (int e = 0; e < 8; ++e) f[e] = wpf[(size_t)(g * 128 + 32 * ks + 8 * fq + e) * 1024 + n];
            u32x4 w; w.x = pk2(f[0], f[1]); w.y = pk2(f[2], f[3]); w.z = pk2(f[4], f[5]); w.w = pk2(f[6], f[7]); bw[ks] = __builtin_bit_cast(bf16x8, w); }
#pragma unroll 1
        for (int pj = 0; pj < 16; ++pj) { const int part = pj >> 3, jt = pj & 7, j = 16 * jt + fr, sh = part ? 96 : 0;
            f32x4 acc = (f32x4){0.f, 0.f, 0.f, 0.f};
#pragma unroll
            for (int ks = 0; ks < 4; ++ks) { float cc[8];
#pragma unroll
                for (int e = 0; e < 8; ++e) cc[e] = ct128[(j * (32 * ks + 8 * fq + e) + sh) & 127];
                u32x4 w; w.x = pk2(cc[0], cc[1]); w.y = pk2(cc[2], cc[3]); w.z = pk2(cc[4], cc[5]); w.w = pk2(cc[6], cc[7]); acc = __builtin_amdgcn_mfma_f32_16x16x32_bf16(__builtin_bit_cast(bf16x8, w), bw[ks], acc, 0, 0, 0); }
            const float sc = 0.08838834764831845f;
            u32x2 o; o.x = pk2(acc[0] * sc, acc[1] * sc); o.y = pk2(acc[2] * sc, acc[3] * sc);
            *(u32x2*)(X.w(W_P) + (size_t)1024 * 1024 + (size_t)n * 1024 + part * 512 + g * 128 + 16 * jt + 4 * fq) = o; }
      } }
    if (X.l == 0) {
        const int* pos = (const int*)X.in[1]; float* cst = (float*)X.misc(M_CS); float* snt = (float*)X.misc(M_SN);
        for (int it = gtid; it < T * 16; it += gsz) { float sv, cv; sincosf((float)pos[it >> 4] * ROPE_INV[it & 15], &sv, &cv); cst[it] = cv; snt[it] = sv; }
    }
    if (X.l == 0) {
        __syncthreads();
        bf16* dft = (bf16*)(X.ws + WS_DFT);
        for (int it = gtid; it < 4 * 1024 * (KF / 8); it += gsz) {
            const int ty = it / (1024 * (KF / 8)), r = it % (1024 * (KF / 8)), jj = r / (KF / 8), n0 = (r % (KF / 8)) * 8; const int kk = 2 * jj + (ty & 1), sh = (ty >> 1) ? 1024 : 0;
            float v[8];
#pragma unroll
            for (int q = 0; q < 8; ++q) { const int m = n0 + q; v[q] = m <= 1024 ? ct4096[(kk * m + sh) & 4095] : 0.f; }
            u32x4 o; o.x = pk2(v[0], v[1]); o.y = pk2(v[2], v[3]); o.z = pk2(v[4], v[5]); o.w = pk2(v[6], v[7]);
            *(u32x4*)(dft + ((size_t)ty * 1024 + jj) * KF + n0) = o;
        }
    }
    __syncthreads();
}

__device__ __forceinline__ void phase_norm(const Ctx& X, const float* xin, int mode, const float* gain, bf16* hb, unsigned char* hb8, const int wv) {
    constexpr int R = 4;
    const int tid = tid_(wv); const int lane = tid & 63, gw = (blockIdx.x * blockDim.x + tid) >> 6, ngw = (gridDim.x * blockDim.x) >> 6;
    const int* sot = (const int*)X.misc(M_SOT); const bf16* ys = X.act(A_YSLOT);
    const float* src = mode ? (const float*)X.out : xin; const bf16* xbs = X.act(A_XB);
    for (int t0 = gw; t0 < T; t0 += R * ngw) {
        f32x4 v[R][4]; int s0[R], s1[R];
#pragma unroll
        for (int r = 0; r < R; ++r) { const int t = t0 + r * ngw; s0[r] = 0; s1[r] = 0; if (mode == 1 && t < T) { s0[r] = sot[2 * t]; s1[r] = sot[2 * t + 1]; } }
#pragma unroll
        for (int r = 0; r < R; ++r) { const int t = t0 + r * ngw; if (t < T) {
            if (mode == 1) { const u32x2* xr = (const u32x2*)(xbs + (size_t)t * D) + lane;
#pragma unroll
                for (int j = 0; j < 4; ++j) { const u32x2 a = xr[64 * j]; v[r][j] = (f32x4){bf2f(a.x & 0xffffu), bf2f(a.x >> 16), bf2f(a.y & 0xffffu), bf2f(a.y >> 16)}; } }
            else { const f32x4* xr = (const f32x4*)(src + (size_t)t * D) + lane;
#pragma unroll
                for (int j = 0; j < 4; ++j) v[r][j] = xr[64 * j]; } } }
        if (mode == 1) {
            u32x2 ya[R][4], yb[R][4];
#pragma unroll
            for (int r = 0; r < R; ++r) { const int t = t0 + r * ngw; if (t < T) { const u32x2* y0 = (const u32x2*)(ys + (size_t)s0[r] * D) + lane; const u32x2* y1 = (const u32x2*)(ys + (size_t)s1[r] * D) + lane;
#pragma unroll
                for (int j = 0; j < 4; ++j) { ya[r][j] = y0[64 * j]; yb[r][j] = y1[64 * j]; } } }
#pragma unroll
            for (int r = 0; r < R; ++r) { const int t = t0 + r * ngw; if (t < T) {
#pragma unroll
                for (int j = 0; j < 4; ++j) { const u32x2 a = ya[r][j], b = yb[r][j];
                    v[r][j][0] += bf2f(a.x & 0xffffu) + bf2f(b.x & 0xffffu); v[r][j][1] += bf2f(a.x >> 16) + bf2f(b.x >> 16);
                    v[r][j][2] += bf2f(a.y & 0xffffu) + bf2f(b.y & 0xffffu); v[r][j][3] += bf2f(a.y >> 16) + bf2f(b.y >> 16); }
                if (hb) { u32x2* o = (u32x2*)((bf16*)X.out + (size_t)t * D) + lane;
#pragma unroll
                    for (int j = 0; j < 4; ++j) { u32x2 w; w.x = pk2(v[r][j][0], v[r][j][1]); w.y = pk2(v[r][j][2], v[r][j][3]); o[64 * j] = w; } }
                else { f32x4* o = (f32x4*)(X.out + (size_t)t * D) + lane;
#pragma unroll
                    for (int j = 0; j < 4; ++j) o[64 * j] = v[r][j]; } } }
        }
        if (hb) {
#pragma unroll
            for (int r = 0; r < R; ++r) { const int t = t0 + r * ngw; if (t < T) { float ss = 0.f;
#pragma unroll
                for (int j = 0; j < 4; ++j) ss += (v[r][j][0] * v[r][j][0] + v[r][j][1] * v[r][j][1]) + (v[r][j][2] * v[r][j][2] + v[r][j][3] * v[r][j][3]);
                const float rs = 1.0f / sqrtf(wave_sum(ss) * (1.0f / D) + EPS);
                u32x2* o8 = (u32x2*)(hb + (size_t)t * D) + lane; const f32x4* g4 = (const f32x4*)gain + lane;
                unsigned* q8 = (unsigned*)(hb8 + (size_t)t * D) + lane;
#pragma unroll
                for (int j = 0; j < 4; ++j) { const f32x4 g = g4[64 * j]; const float y0 = v[r][j][0] * rs * g[0], y1 = v[r][j][1] * rs * g[1], y2 = v[r][j][2] * rs * g[2], y3 = v[r][j][3] * rs * g[3];
                    u32x2 w; w.x = pk2(y0, y1); w.y = pk2(y2, y3); o8[64 * j] = w; q8[64 * j] = pk4f8(y0, y1, y2, y3); } } }
        }
    }
}

__device__ __forceinline__ void unpack8(const u32x4 r, float* f) {
    f[0] = bf2f(r.x & 0xffffu); f[1] = bf2f(r.x >> 16); f[2] = bf2f(r.y & 0xffffu); f[3] = bf2f(r.y >> 16);
    f[4] = bf2f(r.z & 0xffffu); f[5] = bf2f(r.z >> 16); f[6] = bf2f(r.w & 0xffffu); f[7] = bf2f(r.w >> 16);
}
__device__ __forceinline__ u32x4 pack8(const float* f) { u32x4 o; o.x = pk2(f[0], f[1]); o.y = pk2(f[2], f[3]); o.z = pk2(f[4], f[5]); o.w = pk2(f[6], f[7]); return o; }
__device__ __forceinline__ float ssq8(const u32x4 r) { float f[8]; unpack8(r, f); float s = 0.f;
#pragma unroll
    for (int j = 0; j < 8; ++j) s += f[j] * f[j];
    return s; }
__device__ __forceinline__ void phase_sgu(const Ctx& X, LAS float* stat  , const int wv) {
    typedef float f32x16 __attribute__((ext_vector_type(16)));
    const int tid = tid_(wv); const int lane = tid & 63, wid = __builtin_amdgcn_readfirstlane(tid >> 6), r32 = lane & 31, hi = lane >> 5;
    const bf16* ug = X.act(A_SGU); const bf16* vt = X.act(A_VT); bf16* ysg = X.act(A_YAS) + 512; const bf16* wsb = X.w(W_S);
    const float* lng = X.inp(10, 512); const float* lnb = X.inp(11, 512); const float* bs = X.inp(13, (size_t)8 * 128);
    LAS float* red = stat + 256;
    for (int un = blockIdx.x; un < T / 128; un += gridDim.x) {
        const bf16* vt_ = vt; const bf16* ug_ = ug; bf16* ysg_ = ysg; const bf16* wsb_ = wsb;
        asm volatile("" : "+s"(vt_), "+s"(ug_), "+s"(ysg_), "+s"(wsb_));
        const int b = un >> 5, ck = un & 31, t0 = un * 128; const bf16* vtile = vt_ + (size_t)b * 512 * 4096 + ck * 128;
        const int g = wid;
        u32x4 vraw[8][2];
        { const int chg = lane >> 4, oct = lane & 15; u32x4 sv[16];
          { const unsigned soff = (unsigned)((chg * 4096 + 8 * oct) * 2);
            const char* sb = (const char*)(vtile + (size_t)(wid * 64) * 4096);
#pragma unroll
            for (int i = 0; i < 16; ++i) sv[i] = *(const u32x4*)(sb + (size_t)i * (4 * 4096 * 2) + soff); }
          float s1[8], s2[8];
#pragma unroll
          for (int j = 0; j < 8; ++j) { s1[j] = 0.f; s2[j] = 0.f; }
#pragma unroll
          for (int i = 0; i < 16; ++i) { float f[8]; unpack8(sv[i], f);
#pragma unroll
              for (int j = 0; j < 8; ++j) { s1[j] += f[j]; s2[j] += f[j] * f[j]; } }
          asm volatile("" ::: "memory");
#pragma unroll
          for (int ks = 0; ks < 8; ++ks)
#pragma unroll
              for (int cb = 0; cb < 2; ++cb) vraw[ks][cb] = *(const u32x4*)((const char*)(vtile + (size_t)(g * 64 + cb * 32) * 4096 + ks * 16) + (unsigned)((r32 * 4096 + 8 * hi) * 2));
#pragma unroll
          for (int j = 0; j < 8; ++j) { s1[j] += __shfl_xor(s1[j], 16); s1[j] += __shfl_xor(s1[j], 32); s2[j] += __shfl_xor(s2[j], 16); s2[j] += __shfl_xor(s2[j], 32); }
          __syncthreads();
          if (chg == 0) {
#pragma unroll
              for (int j = 0; j < 8; ++j) { red[((wid * 128) + 8 * oct + j) * 2] = s1[j]; red[((wid * 128) + 8 * oct + j) * 2 + 1] = s2[j]; } } }
        __syncthreads();
        if (tid < 128) { float s1 = 0.f, s2 = 0.f;
#pragma unroll
            for (int pp = 0; pp < 8; ++pp) { s1 += red[(pp * 128 + tid) * 2]; s2 += red[(pp * 128 + tid) * 2 + 1]; }
            const float mu = s1 * (1.0f / 512.0f), var = fmaxf(s2 * (1.0f / 512.0f) - mu * mu, 0.f);
            stat[2 * tid] = mu; stat[2 * tid + 1] = 1.0f / sqrtf(var + EPS); }
        __syncthreads();
        float gam[2], bet[2];
#pragma unroll
        for (int cb = 0; cb < 2; ++cb) { gam[cb] = lng[g * 64 + cb * 32 + r32]; bet[cb] = lnb[g * 64 + cb * 32 + r32]; }
        bf16x8 bfr[8][2];
#pragma unroll
        for (int ks = 0; ks < 8; ++ks) {
            const int q0 = ks * 16 + 8 * hi;
            float mu[8], rs[8];
#pragma unroll
            for (int j = 0; j < 8; ++j) { mu[j] = stat[2 * (q0 + j)]; rs[j] = stat[2 * (q0 + j) + 1]; }
#pragma unroll
            for (int cb = 0; cb < 2; ++cb) { const u32x4 raw = vraw[ks][cb];
                float f[8] = {bf2f(raw.x & 0xffffu), bf2f(raw.x >> 16), bf2f(raw.y & 0xffffu), bf2f(raw.y >> 16), bf2f(raw.z & 0xffffu), bf2f(raw.z >> 16), bf2f(raw.w & 0xffffu), bf2f(raw.w >> 16)};
#pragma unroll
                for (int j = 0; j < 8; ++j) f[j] = (f[j] - mu[j]) * rs[j] * gam[cb] + bet[cb];
                u32x4 w; w.x = pk2(f[0], f[1]); w.y = pk2(f[2], f[3]); w.z = pk2(f[4], f[5]); w.w = pk2(f[6], f[7]);
                bfr[ks][cb] = *reinterpret_cast<bf16x8*>(&w); }
        }
        const unsigned woff = (unsigned)((r32 * 128 + 8 * hi) * 2), uoff = (unsigned)((r32 * 512 + 4 * hi) * 2), yoff = (unsigned)((r32 * 1024 + 4 * hi) * 2);
#pragma unroll
        for (int pb = 0; pb < 4; ++pb) {
            bf16x8 wf[8]; u32x2 uu[2][4];
            const char* wb = (const char*)(wsb_ + ((size_t)g * 128 + pb * 32) * 128); const char* ub = (const char*)(ug_ + (size_t)(t0 + pb * 32) * 512 + g * 64);
#pragma unroll
            for (int ks = 0; ks < 8; ++ks) wf[ks] = *(const bf16x8*)(wb + ks * 32 + woff);
            const float bias = bs[g * 128 + pb * 32 + r32];
#pragma unroll
            for (int cb = 0; cb < 2; ++cb)
#pragma unroll
                for (int k = 0; k < 4; ++k) uu[cb][k] = *(const u32x2*)(ub + (cb * 32 + 8 * k) * 2 + uoff);
            f32x16 acc[2];
#pragma unroll
            for (int cb = 0; cb < 2; ++cb) acc[cb] = f32x16{};
#pragma unroll
            for (int ks = 0; ks < 8; ++ks)
#pragma unroll
                for (int cb = 0; cb < 2; ++cb) acc[cb] = __builtin_amdgcn_mfma_f32_32x32x16_bf16(bfr[ks][cb], wf[ks], acc[cb], 0, 0, 0);
            char* yb = (char*)(ysg_ + (size_t)(t0 + pb * 32) * 1024 + g * 64);
#pragma unroll
            for (int cb = 0; cb < 2; ++cb)
#pragma unroll
                for (int k = 0; k < 4; ++k) { const u32x2 uv = uu[cb][k]; u32x2 o;
                    o.x = pk2(bf2f(uv.x & 0xffffu) * (acc[cb][4 * k] + bias), bf2f(uv.x >> 16) * (acc[cb][4 * k + 1] + bias));
                    o.y = pk2(bf2f(uv.y & 0xffffu) * (acc[cb][4 * k + 2] + bias), bf2f(uv.y >> 16) * (acc[cb][4 * k + 3] + bias));
                    *(u32x2*)(yb + (cb * 32 + 8 * k) * 2 + yoff) = o; }
            asm volatile("" ::: "memory");
        }
    }
    { const int tid = tid_(wv), lane = tid & 63;
      const bf16* zt = X.act(A_ZT); bf16* zri = X.act(A_ZRI); const int gw0 = (blockIdx.x * blockDim.x + tid) >> 6, ngw0 = (gridDim.x * blockDim.x) >> 6;
      for (int it = gw0; it < NB * 512; it += ngw0) { const bf16* zr = zt + (size_t)it * 4096 + lane * 64; float a = 0.f;
#pragma unroll
          for (int k = 0; k < 8; ++k) { float f[8]; unpack8(*(const u32x4*)(zr + 8 * k), f); a += (f[0] - f[1]) + (f[2] - f[3]) + (f[4] - f[5]) + (f[6] - f[7]); }
          a = wave_sum(a);
          if (lane == 0) { const int b = it >> 9, ch = it & 511; bf16* o = zri + ((size_t)b * 4096 + 2048) * 1024 + ch; o[0] = (bf16)f2bf(a * 0.015625f); o[512] = 0; } } }
    { const int tid3 = tid_(wv); const int gt = blockIdx.x * blockDim.x + tid3, gs = gridDim.x * blockDim.x; const bf16* zt = X.act(A_ZT); bf16* zf = X.act(A_ZF);
      for (int it = gt; it < NB * 512 * (KF / 8); it += gs) {
          const int g8 = it % (KF / 8), bc = it / (KF / 8), b = bc >> 9, ch = bc & 511, m0 = g8 * 8; const bf16* zr = zt + (size_t)bc * 4096;
          float ee[8], eo[8], oe[8], oo[8];
#pragma unroll
          for (int j = 0; j < 8; ++j) { ee[j] = 0.f; eo[j] = 0.f; oe[j] = 0.f; oo[j] = 0.f; }
          if (m0 < 1024) { float a[8], d[8], ra[8], rb[8]; unpack8(*(const u32x4*)(zr + m0), a); unpack8(*(const u32x4*)(zr + 2048 + m0), d);
              unpack8(*(const u32x4*)(zr + 4096 - m0 - 8), ra); unpack8(*(const u32x4*)(zr + 2048 - m0 - 8), rb);
              if (m0 == 0) { ee[0] = a[0] + d[0]; eo[0] = a[0] - d[0]; }
              else { const float pa = bf2f(zr[4096 - m0]), pb = bf2f(zr[2048 - m0]); const float e1 = a[0] + pa, e2 = pb + d[0], o1 = a[0] - pa, o2 = pb - d[0];
                  ee[0] = e1 + e2; eo[0] = e1 - e2; oe[0] = o1 - o2; oo[0] = o1 + o2; }
#pragma unroll
              for (int j = 1; j < 8; ++j) { const float e1 = a[j] + ra[8 - j], e2 = rb[8 - j] + d[j], o1 = a[j] - ra[8 - j], o2 = rb[8 - j] - d[j];
                  ee[j] = e1 + e2; eo[j] = e1 - e2; oe[j] = o1 - o2; oo[j] = o1 + o2; } }
          else if (m0 == 1024) { const float a0 = bf2f(zr[1024]), d0 = bf2f(zr[3072]); ee[0] = a0 + d0; oo[0] = a0 - d0; }
          bf16* o = zf + ((size_t)(b * 4) * 512 + ch) * KF + m0;
          *(u32x4*)(o) = pack8(ee); *(u32x4*)(o + (size_t)512 * KF) = pack8(eo); *(u32x4*)(o + (size_t)2 * 512 * KF) = pack8(oe); *(u32x4*)(o + (size_t)3 * 512 * KF) = pack8(oo);
      } }
    const int tid2 = tid_(wv), lane2 = tid2 & 63;
    const int gw = (blockIdx.x * blockDim.x + tid2) >> 6, ngw = (gridDim.x * blockDim.x) >> 6;
    const bf16* lat = X.act(A_LAT); float* rsq = (float*)X.misc(M_RSQ); float* rskv = (float*)X.misc(M_RSKV);
    const int li = lane2 & 15, tg = lane2 >> 4;
    for (int t4 = gw; t4 < T / 4; t4 += ngw) {
        const int t = t4 * 4 + tg; const bf16* r = lat + (size_t)t * 768 + li * 8;
        u32x4 c[5];
#pragma unroll
        for (int k = 0; k < 5; ++k) c[k] = *(const u32x4*)(r + 128 * k);
        float sq = ssq8(c[0]) + ssq8(c[1]) + ssq8(c[2]), sk = ssq8(c[3]) + ssq8(c[4]);
#pragma unroll
        for (int o = 1; o < 16; o <<= 1) { sq += __shfl_xor(sq, o); sk += __shfl_xor(sk, o); }
        if (li == 0) { rsq[t] = 1.0f / sqrtf(sq * (1.0f / 384.0f) + EPS); rskv[t] = 1.0f / sqrtf(sk * (1.0f / 256.0f) + EPS); }
    }
}

__device__ __forceinline__ void rope_store(const bf16* src32, float mul, const float* gain, const float* cs, const float* sn, float post, bf16* dst) {
    float a[16], b[16];
    unpack8(*(const u32x4*)(src32), a); unpack8(*(const u32x4*)(src32 + 8), a + 8); unpack8(*(const u32x4*)(src32 + 16), b); unpack8(*(const u32x4*)(src32 + 24), b + 8);
#pragma unroll
    for (int i = 0; i < 16; ++i) { const float x1 = a[i] * mul * gain[64 + i], x2 = b[i] * mul * gain[80 + i]; a[i] = (x1 * cs[i] - x2 * sn[i]) * post; b[i] = (x1 * sn[i] + x2 * cs[i]) * post; }
    *(u32x4*)(dst + 64) = pack8(a); *(u32x4*)(dst + 72) = pack8(a + 8); *(u32x4*)(dst + 80) = pack8(b); *(u32x4*)(dst + 88) = pack8(b + 8);
}
__device__ __forceinline__ void phase_prep(const Ctx& X, const int wv) {
    const int tid = tid_(wv); const int lane = tid & 63, sub = lane & 7, hd = lane >> 3, q4 = sub & 3, ii = 8 * (q4 & 1);
    const int gw = (blockIdx.x * blockDim.x + tid) >> 6, ngw = (gridDim.x * blockDim.x) >> 6;
    const bf16* kv = X.act(A_KV); bf16* kb = X.act(A_KB); const bf16* lat = X.act(A_LAT);
    const float* kn = X.inp(9, QKH); const float* cst = (const float*)X.misc(M_CS); const float* snt = (const float*)X.misc(M_SN);
    float gn[8], g1[8], g2[8];
#pragma unroll
    for (int j = 0; j < 8; ++j) { gn[j] = kn[8 * sub + j]; g1[j] = kn[64 + ii + j]; g2[j] = kn[80 + ii + j]; }
    constexpr int U = 4;
    for (int t0 = gw; t0 < T; t0 += U * ngw) {
        u32x4 nk[U], ro[U], rq[U]; f32x4 c0[U], c1[U], s0[U], s1[U];
#pragma unroll
        for (int u = 0; u < U; ++u) { const int t = t0 + u * ngw; nk[u] = (u32x4){0u, 0u, 0u, 0u}; ro[u] = nk[u]; rq[u] = nk[u]; c0[u] = (f32x4){0.f, 0.f, 0.f, 0.f}; c1[u] = c0[u]; s0[u] = c0[u]; s1[u] = c0[u];
            if (t < T) { nk[u] = *(const u32x4*)(kv + (size_t)t * 1024 + hd * 128 + 8 * sub);
                if (sub < 4) { const bf16* rp = lat + (size_t)t * 768 + 640; ro[u] = *(const u32x4*)(rp + 8 * q4); rq[u] = *(const u32x4*)(rp + 8 * (q4 ^ 2));
                    const f32x4* cp = (const f32x4*)(cst + (size_t)t * 16 + ii); const f32x4* sp = (const f32x4*)(snt + (size_t)t * 16 + ii); c0[u] = cp[0]; c1[u] = cp[1]; s0[u] = sp[0]; s1[u] = sp[1]; } } }
#pragma unroll
        for (int u = 0; u < U; ++u) { const int t = t0 + u * ngw;
            float ss = ssq8(nk[u]) + (sub < 4 ? ssq8(ro[u]) : 0.f);
            ss += __shfl_xor(ss, 1); ss += __shfl_xor(ss, 2); ss += __shfl_xor(ss, 4);
            const float r2 = 1.0f / sqrtf(ss * (1.0f / 96.0f) + EPS);
            if (t < T) { bf16* ko = kb + (size_t)t * 768 + hd * 96;
                float f[8]; unpack8(nk[u], f);
#pragma unroll
                for (int j = 0; j < 8; ++j) f[j] = f[j] * r2 * gn[j];
                *(u32x4*)(ko + 8 * sub) = pack8(f);
                if (sub < 4) { float a[8], b[8]; unpack8(q4 < 2 ? ro[u] : rq[u], a); unpack8(q4 < 2 ? rq[u] : ro[u], b);
#pragma unroll
                    for (int j = 0; j < 8; ++j) { const float cc = j < 4 ? c0[u][j & 3] : c1[u][j & 3], sn_ = j < 4 ? s0[u][j & 3] : s1[u][j & 3]; const float x1 = a[j] * r2 * g1[j], x2 = b[j] * r2 * g2[j];
                        f[j] = q4 < 2 ? x1 * cc - x2 * sn_ : x1 * sn_ + x2 * cc; }
                    *(u32x4*)(ko + 64 + 8 * q4) = pack8(f); } } }
    }
}

__device__ __forceinline__ void phase_attn_naive(const Ctx& X, const int wv) {
    const int tid = tid_(wv); const int lane = tid & 63, fr = lane & 15, fq = lane >> 4;
    const int gw = (blockIdx.x * blockDim.x + tid) >> 6, ngw = (gridDim.x * blockDim.x) >> 6;
    const bf16* qb = X.act(A_Q); const bf16* kb = X.act(A_KB); const bf16* kv = X.act(A_KV); bf16* ya = X.act(A_YAS);
    for (int un = gw; un < NB * NH * (SEQ / 16); un += ngw) {
        const int qt = un & 255, h = (un >> 8) & 7, b = un >> 11; const int tq = b * SEQ + qt * 16;
        bf16x8 qf[3];
#pragma unroll
        for (int s = 0; s < 3; ++s) qf[s] = *(const bf16x8*)(qb + (size_t)(tq + fr) * 768 + h * 96 + s * 32 + 8 * fq);
        f32x4 o[4]; for (int d = 0; d < 4; ++d) o[d] = (f32x4){0.f, 0.f, 0.f, 0.f};
        float m = -1e30f, l = 0.f;
        for (int k0 = 0; k0 < SEQ; k0 += 32) {
            const int tk = b * SEQ + k0;
            f32x4 s0 = (f32x4){0.f, 0.f, 0.f, 0.f}, s1 = s0;
#pragma unroll
            for (int s = 0; s < 3; ++s) {
                const bf16x8 k0f = *(const bf16x8*)(kb + (size_t)(tk + fr) * 768 + h * 96 + s * 32 + 8 * fq);
                const bf16x8 k1f = *(const bf16x8*)(kb + (size_t)(tk + 16 + fr) * 768 + h * 96 + s * 32 + 8 * fq);
                s0 = __builtin_amdgcn_mfma_f32_16x16x32_bf16(k0f, qf[s], s0, 0, 0, 0);
                s1 = __builtin_amdgcn_mfma_f32_16x16x32_bf16(k1f, qf[s], s1, 0, 0, 0);
            }
            float mx = fmaxf(fmaxf(fmaxf(s0[0], s0[1]), fmaxf(s0[2], s0[3])), fmaxf(fmaxf(s1[0], s1[1]), fmaxf(s1[2], s1[3])));
            mx = fmaxf(mx, __shfl_xor(mx, 16)); mx = fmaxf(mx, __shfl_xor(mx, 32));
            const float mn = fmaxf(m, mx), al = exp2f(m - mn); m = mn;
            float p[8]; float ps = 0.f;
#pragma unroll
            for (int j = 0; j < 4; ++j) { p[j] = exp2f(s0[j] - mn); p[4 + j] = exp2f(s1[j] - mn); ps += p[j] + p[4 + j]; }
            l = l * al + ps;
            bf16x8 pf;
#pragma unroll
            for (int j = 0; j < 8; ++j) pf[j] = (short)f2bf(p[j]);
#pragma unroll
            for (int d = 0; d < 4; ++d) {
                bf16x8 vf;
#pragma unroll
                for (int j = 0; j < 8; ++j) { const int key = tk + (j < 4 ? 4 * fq + j : 16 + 4 * fq + (j - 4)); vf[j] = (short)kv[(size_t)key * 1024 + h * 128 + 64 + d * 16 + fr]; }
                o[d] = o[d] * al;
                o[d] = __builtin_amdgcn_mfma_f32_16x16x32_bf16(vf, pf, o[d], 0, 0, 0);
            }
        }
        l += __shfl_xor(l, 16); l += __shfl_xor(l, 32);
        const float il = 1.0f / l;
#pragma unroll
        for (int d = 0; d < 4; ++d) { u32x2 w; w.x = pk2(o[d][0] * il, o[d][1] * il); w.y = pk2(o[d][2] * il, o[d][3] * il);
            *(u32x2*)(ya + (size_t)(tq + fr) * 1024 + h * 64 + d * 16 + 4 * fq) = w; }
    }
}

namespace at {
typedef float f32x16 __attribute__((ext_vector_type(16)));
typedef short s16x4 __attribute__((ext_vector_type(4)));
constexpr int SHM_V = 64 * 64 * 2, SHM_K = 64 * 256, LDS_NEED = 3 * SHM_V + 3 * SHM_K + 8 * 64 * 4;
constexpr float THR2 = 11.5f;
#define KSWZ(row, colB) ((row) * 256 + ((colB) ^ (((row) & 15) << 4)))
#define SBAR() __builtin_amdgcn_sched_barrier(0)
__device__ __forceinline__ int crow(int r, int hi) { return (r & 3) + 8 * (r >> 2) + 4 * hi; }
__device__ __forceinline__ unsigned cvtpk(float lo, float hi) { unsigned r; asm volatile("v_cvt_pk_bf16_f32 %0, %1, %2" : "=v"(r) : "v"(lo), "v"(hi)); return r; }
__device__ __forceinline__ void decide(f32x16& p0, f32x16& p1, float& m_reg, f32x16& negm, float& alpha) {
    float pmax = p0[0];
#pragma unroll
    for (int r = 1; r < 16; ++r) pmax = fmaxf(pmax, p0[r]);
#pragma unroll
    for (int r = 0; r < 16; ++r) pmax = fmaxf(pmax, p1[r]);
    { auto rr = __builtin_amdgcn_permlane32_swap(__float_as_uint(pmax), __float_as_uint(pmax), false, false); pmax = fmaxf(__uint_as_float(rr[0]), __uint_as_float(rr[1])); }
    alpha = 1.f;
    if (__builtin_expect(!__all(pmax <= THR2), 0)) {
        const float dl = fmaxf(pmax, 0.f); m_reg += dl; alpha = __builtin_amdgcn_exp2f(-dl);
#pragma unroll
        for (int r = 0; r < 16; ++r) { p0[r] -= dl; p1[r] -= dl; negm[r] = -m_reg; }
    }
}
__device__ __forceinline__ void exp8(f32x16& p, int base) {
#pragma unroll
    for (int r = 0; r < 8; ++r) p[base + r] = __builtin_amdgcn_exp2f(p[base + r]);
}
__device__ __forceinline__ void finishSM(f32x16& p0, f32x16& p1, bf16x8& pa0, bf16x8& pa1, bf16x8& pa2, bf16x8& pa3) {
#pragma unroll
    for (int r = 0; r < 16; ++r) p1[r] = __builtin_amdgcn_exp2f(p1[r]);
#define PK4(P, BASE, OUT) do { u32x4 w = {cvtpk(P[BASE + 0], P[BASE + 1]), cvtpk(P[BASE + 2], P[BASE + 3]), cvtpk(P[BASE + 4], P[BASE + 5]), cvtpk(P[BASE + 6], P[BASE + 7])}; OUT = *reinterpret_cast<bf16x8*>(&w); } while (0)
    PK4(p0, 0, pa0); PK4(p0, 8, pa1); PK4(p1, 0, pa2); PK4(p1, 8, pa3);
#undef PK4
}
__device__ __forceinline__ void qkt(f32x16& p0, f32x16& p1, const char* Ks, const bf16x8* qr, const f32x16& negm, int r32, int hi) {
#pragma unroll
    for (int d0 = 0; d0 < 6; ++d0) { const int cb = (d0 * 16 + hi * 8) * 2;
        const bf16x8 b0 = *reinterpret_cast<const bf16x8*>(Ks + KSWZ(r32, cb));
        const bf16x8 b1 = *reinterpret_cast<const bf16x8*>(Ks + KSWZ(32 + r32, cb));
        if (d0 == 0) { p0 = __builtin_amdgcn_mfma_f32_32x32x16_bf16(b0, qr[0], negm, 0, 0, 0); p1 = __builtin_amdgcn_mfma_f32_32x32x16_bf16(b1, qr[0], negm, 0, 0, 0); }
        else { p0 = __builtin_amdgcn_mfma_f32_32x32x16_bf16(b0, qr[d0], p0, 0, 0, 0); p1 = __builtin_amdgcn_mfma_f32_32x32x16_bf16(b1, qr[d0], p1, 0, 0, 0); } }
}
__device__ __forceinline__ int v_st(int k, int c) { const int kk = (k & ~0xC) | ((k & 4) << 1) | ((k & 8) >> 1); return ((kk >> 3) * 2 + (c >> 5)) * 512 + ((kk & 7) * 32 + (c & 31)) * 2; }
__device__ __forceinline__ int v_rd_base(int lane) { return ((lane & 3) << 3) | (((lane >> 2) & 3) << 6) | (((lane >> 4) & 1) << 5) | (((lane >> 5) & 1) << 8); }
constexpr int v_rd_off(int d0, int ks, int half) { return d0 * 512 + ks * 2048 + half * 1024; }
template <int OFF> __device__ __forceinline__ s16x4 tr_read(int vb) { s16x4 r; asm volatile("ds_read_b64_tr_b16 %0, %1 offset:%2" : "=&v"(r) : "v"(vb), "i"(OFF) : "memory"); return r; }
template <int D0> __device__ __forceinline__ void pv_one(f32x16& od, int vb, bf16x8 pa0, bf16x8 pa1, bf16x8 pa2, bf16x8 pa3) {
    const s16x4 l0 = tr_read<v_rd_off(D0, 0, 0)>(vb), h0 = tr_read<v_rd_off(D0, 0, 1)>(vb), l1 = tr_read<v_rd_off(D0, 1, 0)>(vb), h1 = tr_read<v_rd_off(D0, 1, 1)>(vb);
    const s16x4 l2 = tr_read<v_rd_off(D0, 2, 0)>(vb), h2 = tr_read<v_rd_off(D0, 2, 1)>(vb), l3 = tr_read<v_rd_off(D0, 3, 0)>(vb), h3 = tr_read<v_rd_off(D0, 3, 1)>(vb);
    asm volatile("s_waitcnt lgkmcnt(0)" ::: "memory"); SBAR();
#define PK(L, H) (bf16x8){L[0], L[1], L[2], L[3], H[0], H[1], H[2], H[3]}
    od = __builtin_amdgcn_mfma_f32_32x32x16_bf16(pa0, PK(l0, h0), od, 0, 0, 0);
    od = __builtin_amdgcn_mfma_f32_32x32x16_bf16(pa1, PK(l1, h1), od, 0, 0, 0);
    od = __builtin_amdgcn_mfma_f32_32x32x16_bf16(pa2, PK(l2, h2), od, 0, 0, 0);
    od = __builtin_amdgcn_mfma_f32_32x32x16_bf16(pa3, PK(l3, h3), od, 0, 0, 0);
#undef PK
}
__device__ __forceinline__ void psum(f32x16& osum, bf16x8 ones, bf16x8 pa0, bf16x8 pa1, bf16x8 pa2, bf16x8 pa3) {
    osum = __builtin_amdgcn_mfma_f32_32x32x16_bf16(pa0, ones, osum, 0, 0, 0); osum = __builtin_amdgcn_mfma_f32_32x32x16_bf16(pa1, ones, osum, 0, 0, 0);
    osum = __builtin_amdgcn_mfma_f32_32x32x16_bf16(pa2, ones, osum, 0, 0, 0); osum = __builtin_amdgcn_mfma_f32_32x32x16_bf16(pa3, ones, osum, 0, 0, 0);
}
__device__ __forceinline__ void pv_d0(f32x16* o, f32x16& osum, bf16x8 ones, int vb, bf16x8 pa0, bf16x8 pa1, bf16x8 pa2, bf16x8 pa3) { psum(osum, ones, pa0, pa1, pa2, pa3); pv_one<0>(o[0], vb, pa0, pa1, pa2, pa3); pv_one<1>(o[1], vb, pa0, pa1, pa2, pa3); }
__device__ __forceinline__ void pv_exp(f32x16* o, f32x16& osum, bf16x8 ones, int vb, bf16x8 pa0, bf16x8 pa1, bf16x8 pa2, bf16x8 pa3, f32x16& pn) { psum(osum, ones, pa0, pa1, pa2, pa3); pv_one<0>(o[0], vb, pa0, pa1, pa2, pa3); exp8(pn, 0); pv_one<1>(o[1], vb, pa0, pa1, pa2, pa3); exp8(pn, 8); }

__device__ __forceinline__ void unit(const bf16* __restrict__ Qb, const bf16* __restrict__ Kh, const bf16* __restrict__ Vh, bf16* __restrict__ Ob, const float* __restrict__ qn, const float* __restrict__ cst, const float* __restrict__ snt, int tok0, float gmk, char* lds, LAS unsigned char* L3, int tid) {
    const int wid = __builtin_amdgcn_readfirstlane(tid >> 6), lane = tid & 63, r32 = lane & 31, hi = lane >> 5;
    const bf16* Qw = Qb + (unsigned)((wid * 32 + r32) * 768 + hi * 8); bf16* Ow = Ob + (unsigned)(wid * 32 * 1024);
    char* V_lds = lds; char* K_lds = lds + 3 * SHM_V;
    float* ws = (float*)(lds + 3 * SHM_V + 3 * SHM_K) + wid * 64; float* li_l = ws; float* al_l = ws + 32;
    bf16x8 qr[6];
    f32x16 negm = f32x16{}; asm volatile("" : "+v"(negm));
    {
        float qf[6][8]; float ss = 0.f;
#pragma unroll
        for (int d0 = 0; d0 < 6; ++d0) { unpack8(*reinterpret_cast<const u32x4*>(Qw + d0 * 16), qf[d0]);
#pragma unroll
            for (int j = 0; j < 8; ++j) ss += qf[d0][j] * qf[d0][j]; }
        { auto rr = __builtin_amdgcn_permlane32_swap(__float_as_uint(ss), __float_as_uint(ss), false, false); ss = __uint_as_float(rr[0]) + __uint_as_float(rr[1]); }
        const float mul = QSCALE / sqrtf(ss * (1.0f / 96.0f) + EPS);
#pragma unroll
        for (int d0 = 0; d0 < 6; ++d0) { const f32x4 g0 = *(const f32x4*)(qn + d0 * 16 + hi * 8), g1 = *(const f32x4*)(qn + d0 * 16 + hi * 8 + 4);
#pragma unroll
            for (int j = 0; j < 4; ++j) { qf[d0][j] *= mul * g0[j]; qf[d0][4 + j] *= mul * g1[j]; } }
        { const float* cp = cst + (size_t)(tok0 + wid * 32 + r32) * 16 + hi * 8; const float* sp = snt + (size_t)(tok0 + wid * 32 + r32) * 16 + hi * 8;
          const f32x4 c0 = *(const f32x4*)cp, c1 = *(const f32x4*)(cp + 4), s0_ = *(const f32x4*)sp, s1_ = *(const f32x4*)(sp + 4);
#pragma unroll
          for (int j = 0; j < 8; ++j) { const float c = j < 4 ? c0[j & 3] : c1[j & 3], sn_ = j < 4 ? s0_[j & 3] : s1_[j & 3]; const float a = qf[4][j], b = qf[5][j]; qf[4][j] = a * c - b * sn_; qf[5][j] = a * sn_ + b * c; } }
        float q2 = 0.f;
#pragma unroll
        for (int d0 = 0; d0 < 6; ++d0) { const u32x4 w = pack8(qf[d0]); qr[d0] = __builtin_bit_cast(bf16x8, w);
            float qq[8]; unpack8(w, qq);
#pragma unroll
            for (int j = 0; j < 8; ++j) q2 += qq[j] * qq[j]; }
        { auto rr = __builtin_amdgcn_permlane32_swap(__float_as_uint(q2), __float_as_uint(q2), false, false); q2 = __uint_as_float(rr[0]) + __uint_as_float(rr[1]); }
        const float mrow = fminf(sqrtf(q2) * gmk * 1.002f + 0.05f, 100.0f);
#pragma unroll
        for (int r = 0; r < 16; ++r) negm[r] = -mrow;
        asm volatile("" : "+v"(negm));
    }
    f32x16 o[2] = {}, osum = {}; const short one_ = (r32 == 0) ? (short)0x3F80 : (short)0; const bf16x8 ones = (bf16x8){one_, one_, one_, one_, one_, one_, one_, one_};
    const int krow0 = wid * 8 + (lane >> 4), kslot = lane & 15;
    int kc0 = kslot ^ (krow0 & 15), kc1 = kslot ^ ((krow0 + 4) & 15); kc0 = kc0 < 12 ? kc0 : kc0 - 12; kc1 = kc1 < 12 ? kc1 : kc1 - 12;
    const unsigned koff0 = (unsigned)(krow0 * 768 + kc0 * 8) * 2u, koff1 = (unsigned)((krow0 + 4) * 768 + kc1 * 8) * 2u;
    const int vkey = wid * 8 + ((lane & 31) >> 2);
    const unsigned voff = (unsigned)(vkey * 1024 + (lane >> 5) * 32 + (lane & 3) * 8) * 2u;
    const int vb0 = (int)(uintptr_t)V_lds + v_rd_base(lane);
#define DMA(slot, t) do { const char* kt = (const char*)Kh + (size_t)(t) * (64 * 768 * 2); const char* vt = (const char*)Vh + (size_t)(t) * (64 * 1024 * 2); \
    __builtin_amdgcn_global_load_lds((const unsigned*)(kt + koff0), (LAS unsigned*)(L3 + 3 * SHM_V + (slot) * SHM_K + wid * 2048), 16, 0, 0); \
    __builtin_amdgcn_global_load_lds((const unsigned*)(kt + koff1), (LAS unsigned*)(L3 + 3 * SHM_V + (slot) * SHM_K + wid * 2048 + 1024), 16, 0, 0); \
    __builtin_amdgcn_global_load_lds((const unsigned*)(vt + voff), (LAS unsigned*)(L3 + (slot) * SHM_V + wid * 1024), 16, 0, 0); } while (0)
#define DMA_WAIT_BAR() do { asm volatile("s_waitcnt vmcnt(0)" ::: "memory"); __syncthreads(); } while (0)
#define RESC(a) do { if (__any((a) < 1.f)) { if (hi == 0) al_l[r32] = (a); asm volatile("s_waitcnt lgkmcnt(0)" ::: "memory"); \
    _Pragma("unroll") for (int d = 0; d < 2; ++d) _Pragma("unroll") for (int r = 0; r < 16; ++r) o[d][r] *= al_l[crow(r, hi)]; } } while (0)
#define NXT(x) ((x) == 2 ? 0 : (x) + 1)
    f32x16 pA0, pA1, pB0, pB1; bf16x8 pa0, pa1, pa2, pa3; constexpr int NT = SEQ / 64;
    DMA(0, 0); DMA(1, 1); DMA_WAIT_BAR();
    qkt(pA0, pA1, K_lds, qr, negm, r32, hi); exp8(pA0, 0); exp8(pA0, 8);
    int s0 = 0;
    for (int t = 0; t + 2 < NT; t += 2) {
        const int s1 = NXT(s0), s2 = NXT(s1);
        DMA(s2, t + 2);
        SBAR(); qkt(pB0, pB1, K_lds + s1 * SHM_K, qr, negm, r32, hi);
        finishSM(pA0, pA1, pa0, pa1, pa2, pa3); SBAR();
        pv_exp(o, osum, ones, vb0 + s0 * SHM_V, pa0, pa1, pa2, pa3, pB0);
        DMA_WAIT_BAR();
        DMA(s0, t + 3);
        SBAR(); qkt(pA0, pA1, K_lds + s2 * SHM_K, qr, negm, r32, hi);
        finishSM(pB0, pB1, pa0, pa1, pa2, pa3); SBAR();
        pv_exp(o, osum, ones, vb0 + s1 * SHM_V, pa0, pa1, pa2, pa3, pA0);
        DMA_WAIT_BAR();
        s0 = s2;
    }
    {
        const int s1 = NXT(s0);
        SBAR(); qkt(pB0, pB1, K_lds + s1 * SHM_K, qr, negm, r32, hi);
        finishSM(pA0, pA1, pa0, pa1, pa2, pa3); SBAR();
        pv_exp(o, osum, ones, vb0 + s0 * SHM_V, pa0, pa1, pa2, pa3, pB0);
        finishSM(pB0, pB1, pa0, pa1, pa2, pa3); SBAR();
        pv_d0(o, osum, ones, vb0 + s1 * SHM_V, pa0, pa1, pa2, pa3);
    }
#undef NXT
#undef DMA
#undef DMA_WAIT_BAR
    if (r32 == 0) {
#pragma unroll
        for (int r = 0; r < 16; ++r) li_l[crow(r, hi)] = osum[r]; }
    asm volatile("s_waitcnt lgkmcnt(0)" ::: "memory");
    float rli[16];
#pragma unroll
    for (int r = 0; r < 16; ++r) rli[r] = __builtin_amdgcn_rcpf(li_l[crow(r, hi)]);
#pragma unroll
    for (int r = 0; r < 16; ++r) { const int orow = crow(r, hi);
#pragma unroll
        for (int d0 = 0; d0 < 2; ++d0) Ow[(long)orow * 1024 + d0 * 32 + r32] = (bf16)f2bf(o[d0][r] * rli[r]); }
    __syncthreads();
#undef RESC
}
#undef KSWZ
#undef SBAR
}
__device__ __forceinline__ void phase_attn_fast(const Ctx& X, char* lds, LAS unsigned char* L3, const int wv) {
    const int tid = tid_(wv);
    const bf16* qb = X.act(A_Q); const bf16* kb = X.act(A_KB); const bf16* kv = X.act(A_KV); bf16* ya = X.act(A_YAS);
    const int G = gridDim.x, c = blockIdx.x; const int vcu = (G % 8 == 0) ? (c % 8) * (G / 8) + c / 8 : c;
    const float gmk = ((const float*)X.misc(M_GMK))[X.l];
    for (int un = vcu; un < NB * NH * (SEQ / 256); un += G) {
        const int qblk = un & 15, h = (un >> 4) & 7, b = un >> 7; const size_t t0 = (size_t)b * SEQ;
        at::unit(qb + (t0 + qblk * 256) * 768 + h * 96, kb + t0 * 768 + h * 96, kv + t0 * 1024 + h * 128 + 64, ya + (t0 + qblk * 256) * 1024 + h * 64,
                 X.inp(8, QKH), (const float*)X.misc(M_CS), (const float*)X.misc(M_SN), (int)t0 + qblk * 256, gmk, lds, L3, tid_(wv));
    }
}

__device__ __forceinline__ void phase_select(const Ctx& X, LAS unsigned* lc  , const int wv) {
    const int tid = tid_(wv);
    const float* lg = (const float*)X.act(A_LOG); const float* bg = X.inp(20, NG); const float* br = X.inp(22, NE);
    int* sele = (int*)X.misc(M_SELE); float* selw = (float*)X.misc(M_SELW); int* selp = (int*)X.misc(M_SELP);
    unsigned* cnt = X.ctl() + CW_CNT + 64 * X.l;
    const float* ssp = (const float*)X.misc(M_SSP); float* rs2 = (float*)X.misc(M_RS2);
    const int G = gridDim.x, per = (T + G - 1) / G;
    for (int i0 = 0; i0 < per; i0 += 512) {
        __syncthreads();
        if (tid < 32) lc[tid] = 0u;
        __syncthreads();
        const int i = i0 + tid, t = blockIdx.x * per + i; const bool on = (i < per) && (t < T);
        int E0 = 0, E1 = 0; unsigned p0 = 0u, p1 = 0u; float w0 = 0.f, w1 = 0.f;
        if (on) {
            const float* r = lg + (size_t)t * 64;
            float ssq = 0.f;
            { const f32x4* sp = (const f32x4*)(ssp + (size_t)t * 16); const f32x4 a = sp[0], b = sp[1], c4 = sp[2], d = sp[3];
              ssq = ((a[0] + a[1]) + (a[2] + a[3])) + ((b[0] + b[1]) + (b[2] + b[3])) + ((c4[0] + c4[1]) + (c4[2] + c4[3])) + ((d[0] + d[1]) + (d[2] + d[3])); }
            const float rsn = 1.0f / sqrtf(ssq * (1.0f / D) + EPS); rs2[t] = rsn;
            float gl[4]; int gs = 0;
#pragma unroll
            for (int q = 0; q < 4; ++q) gl[q] = (r[q] + r[(size_t)T * 64 + q]) * rsn + bg[q];
#pragma unroll
            for (int q = 1; q < 4; ++q) if (gl[q] > gl[gs]) gs = q;
            float den = 0.f;
#pragma unroll
            for (int q = 0; q < 4; ++q) den += expf(gl[q] - gl[gs]);
            const float gw = 1.0f / den;
            float el[8];
#pragma unroll
            for (int q = 0; q < 8; ++q) el[q] = (r[4 + gs * 8 + q] + r[(size_t)T * 64 + 4 + gs * 8 + q]) * rsn + br[gs * 8 + q];
            int q0 = 0;
#pragma unroll
            for (int q = 1; q < 8; ++q) if (el[q] > el[q0]) q0 = q;
            int q1 = (q0 == 0) ? 1 : 0;
#pragma unroll
            for (int q = 0; q < 8; ++q) if (q != q0 && el[q] > el[q1]) q1 = q;
            const float e1 = expf(el[q1] - el[q0]); w0 = gw / (1.0f + e1); w1 = gw * e1 / (1.0f + e1);
            E0 = gs * 8 + q0; E1 = gs * 8 + q1;
            p0 = __hip_atomic_fetch_add(&lc[E0], 1u, __ATOMIC_RELAXED, __HIP_MEMORY_SCOPE_WORKGROUP); p1 = __hip_atomic_fetch_add(&lc[E1], 1u, __ATOMIC_RELAXED, __HIP_MEMORY_SCOPE_WORKGROUP);
        }
        __syncthreads();
        if (tid < 32) { const unsigned n = lc[tid]; lc[32 + tid] = n ? atomicAdd(&cnt[tid], n) : 0u; }
        __syncthreads();
        if (on) { sele[t] = E0 | (E1 << 8); selw[2 * t] = w0; selw[2 * t + 1] = w1; selp[2 * t] = (int)(lc[32 + E0] + p0); selp[2 * t + 1] = (int)(lc[32 + E1] + p1); }
    }
}
__device__ __forceinline__ void moe_table(const Ctx& X, LAS int* tb, const int wv) {
    __syncthreads();
    const int tid = tid_(wv);
    if (tid < 64) {
        const unsigned* cnt = X.ctl() + CW_CNT + 64 * X.l;
        int n = (int)((__hip_atomic_load(&cnt[tid & 31], __ATOMIC_RELAXED, __HIP_MEMORY_SCOPE_AGENT) + 255u) >> 8);
        if (tid >= 32) n = 0;
        int incl = n;
#pragma unroll
        for (int o = 1; o < 32; o <<= 1) { const int v = __shfl_up(incl, o); if (tid >= o) incl += v; }
        const int excl = incl - n;
        if (tid < 32) { tb[tid] = excl; for (int j = 0; j < n; ++j) tb[64 + excl + j] = tid; }
        if (tid == 31) tb[32] = incl;
    }
    __syncthreads();
}
__device__ __forceinline__ void phase_fill(const Ctx& X, LAS int* tb, const int wv) {
    moe_table(X, tb, wv);
    const int tid = tid_(wv); const int gtid = blockIdx.x * blockDim.x + tid, gsz = gridDim.x * blockDim.x;
    const int* sele = (const int*)X.misc(M_SELE); const float* selw = (const float*)X.misc(M_SELW); const int* selp = (const int*)X.misc(M_SELP);
    int* sot = (int*)X.misc(M_SOT); int* tos = (int*)X.misc(M_TOS); float* wos = (float*)X.misc(M_WOS); float* rss = (float*)X.misc(M_RSS); const float* rs2 = (const float*)X.misc(M_RS2);
    const unsigned* cnt = X.ctl() + CW_CNT + 64 * X.l;
    for (int t = gtid; t < T; t += gsz) {
        const int ee = sele[t]; const float rsn = rs2[t];
#pragma unroll
        for (int k = 0; k < 2; ++k) { const int e = (ee >> (8 * k)) & 255; const int slot = tb[e] * 256 + selp[2 * t + k]; sot[2 * t + k] = slot; tos[slot] = t; wos[slot] = selw[2 * t + k]; rss[slot] = rsn; }
    }
    for (int it = gtid; it < 32 * 256; it += gsz) { const int e = it >> 8, j = it & 255; const int c = (int)cnt[e]; const int padn = ((c + 255) & ~255) - c;
        if (j < padn) { const int slot = tb[e] * 256 + c + j; tos[slot] = 0; wos[slot] = 0.f; rss[slot] = 0.f; } }
}

constexpr int NPH = 16;
constexpr int LDS_BYTES = 147456;
constexpr int LDS_MISC = 131072;

__global__ void __launch_bounds__(512, 2) mega(Params p) {
    extern __shared__ __attribute__((aligned(16))) unsigned char lds[];
    LAS unsigned char* L = (LAS unsigned char*)lds;
    volatile LAS unsigned* MISC = (volatile LAS unsigned*)(L + LDS_MISC);
    LAS int* tb = (LAS int*)(L + LDS_MISC + 64);
    LAS float* scr = (LAS float*)(L + LDS_MISC + 2048);
    const int wv = __builtin_amdgcn_readfirstlane(threadIdx.x >> 6);
    if (threadIdx.x < 4) MISC[threadIdx.x] = 0u;
    __syncthreads();
    XcdBarrier bar; bar.bar = (unsigned*)(p.ws + WS_CTL) + CW_BAR; bar.x = 0; bar.st = MISC;
    if (!MK_MULTI) bar = xcd_barrier_post(bar.bar, MISC, wv);
    Ctx X; for (int i = 0; i < 26; ++i) X.in[i] = p.in[i]; X.out = p.out; X.ws = p.ws; X.l = 0;
    const int G = gridDim.x, c = blockIdx.x;
#ifndef PH_MASK
#define PH_MASK 0x1ffffu
#endif
#define IN(g) (((PH_MASK >> ((g) % NPH + ((g) == NPH * NL ? NPH : 0))) & 1u) && p.gp_lo <= (g) && (g) < p.gp_hi)
#ifndef FAST_MASK
#define FAST_MASK 0xffffu
#endif
#ifndef REPEAT_MASK
#define REPEAT_MASK 0u
#endif
#define REP(ph) for (int rep_ = 0; rep_ < (((REPEAT_MASK >> (ph)) & 1u) ? 2 : 1); ++rep_)
#define GEMM(ph, KM, S) do { REP(ph) { if ((FAST_MASK >> (ph)) & 1u) gemm_fast<KM, (ph) == 14>(L, S, E, wv); else gemm_naive<KM>(S, E, wv); } } while (0)
#define SEAM(g) do { if (!MK_MULTI && IN((g) + 1)) xcd_barrier(bar, wv); } while (0)
#define DO_LAYER(LL) { constexpr int l = (LL); \
        X.l = l; const int g0 = NPH * l; \
        Epi E; E.X.ws = p.ws; E.X.out = p.out; E.xres = p.in[0]; E.xresb = (l == 0) ? nullptr : (const bf16*)p.out; \
        if (IN(g0 + 0)) { \
            phase_norm(X, p.in[0], l > 0, X.inp(2, D), X.act(A_HB), (unsigned char*)p.out + HB8_OFF, wv);        \
            REP(0) phase_weights(X, L, wv); \
            SEAM(g0 + 0); \
        } \
        if (IN(g0 + 1)) { SchedG1A S{X.act(A_HB), X.w(W_IN), G, c}; GEMM(1, ((1u << K_LAT) | (1u << K_SGU) | (1u << K_ZT) | (1u << K_VT)), S); SEAM(g0 + 1); } \
        if (IN(g0 + 2)) { REP(2) phase_sgu(X, scr, wv); SEAM(g0 + 2); } \
        if (IN(g0 + 3)) { SchedF2 S{(const bf16*)(p.ws + WS_DFT), X.act(A_ZF), G, c}; GEMM(3, ((1u << K_FNET)), S); SEAM(g0 + 3); } \
        if (IN(g0 + 4)) { SchedG34 S{X.act(A_LAT), X.w(W_UQ), X.w(W_UKV), G, c}; GEMM(4, ((1u << K_QRAW) | (1u << K_KVRAW)), S); SEAM(g0 + 4); } \
        if (IN(g0 + 5)) { phase_prep(X, wv); SEAM(g0 + 5); } \
        if (IN(g0 + 6)) { REP(6) { if ((FAST_MASK >> 6) & 1u) phase_attn_fast(X, (char*)lds, L, wv); else phase_attn_naive(X, wv); } SEAM(g0 + 6); } \
        if (IN(g0 + 8)) { for (int tl = c; tl < 512; tl += G) { int gr = c * 256; asm volatile("" : "+s"(gr)); SchedGate S1{(const bf16*)((const unsigned char*)p.out + HB8_OFF), X.w(W_G), tl, gr}; GEMM(8, ((1u << K_GATE)), S1); SchedMerge S2{X.act(A_YAS), X.act(A_ZRI), X.w(W_P), tl, gr}; GEMM(8, ((1u << K_MERGE)), S2); } SEAM(g0 + 8); } \
        if (IN(g0 + 9)) { SchedG6 S{X.act(A_MERGED), X.w(W_O), G, c, K_OUT, 4}; GEMM(9, ((1u << K_OUT)), S); SEAM(g0 + 9); } \
        if (IN(g0 + 11)) { SchedRT S{X.act(A_XB), X.w(W_R), G, c}; GEMM(11, ((1u << K_ROUTER)), S); SEAM(g0 + 11); } \
        if (IN(g0 + 12)) { phase_select(X, (LAS unsigned*)scr, wv); SEAM(g0 + 12); } \
        if (IN(g0 + 13)) { phase_fill(X, tb, wv); SEAM(g0 + 13); } \
        if (IN(g0 + 14)) { moe_table(X, tb, wv); SchedM1 S{X.act(A_XB), X.w(W_13), (const int*)X.misc(M_TOS), tb, G, c}; GEMM(14, ((1u << K_M1)), S); SEAM(g0 + 14); } \
        if (IN(g0 + 15)) { moe_table(X, tb, wv); SchedM2 S{X.act(A_HID), X.w(W_2), tb, G, c}; GEMM(15, ((1u << K_M2)), S); SEAM(g0 + 15); } \
    }
    DO_LAYER(0)
    DO_LAYER(1)
#undef DO_LAYER
    if (IN(NPH * NL)) { X.l = NL - 1; phase_norm(X, nullptr, 1, nullptr, nullptr, nullptr, wv); }
#undef IN
#undef SEAM
}

extern "C" void kernel_launch(void* const* d_in, const int* in_sizes, int n_in, void* d_out, int out_size, void* d_ws, size_t ws_size, hipStream_t stream) {
    static int ok = 0, grid = 256;
    if (ok == 0) {
        ok = 1;
        { int dev = 0, cus = 0; if (hipGetDevice(&dev) == hipSuccess && hipDeviceGetAttribute(&cus, hipDeviceAttributeMultiprocessorCount, dev) == hipSuccess && cus > 0) grid = cus; }
        if (n_in != 26 || in_sizes[0] != T * D || out_size != T * D || ws_size < WS_NEED) { fprintf(stderr, "kernel_launch: unexpected shapes (n_in %d, in0 %d, out %d, ws %zu < %zu)\n", n_in, n_in > 0 ? in_sizes[0] : -1, out_size, ws_size, (size_t)WS_NEED); ok = -1; }
        else if (hipFuncSetAttribute((const void*)mega, hipFuncAttributeMaxDynamicSharedMemorySize, LDS_BYTES) != hipSuccess) { fprintf(stderr, "kernel_launch: hipFuncSetAttribute failed\n"); ok = -1; }
    }
    if (ok < 0) return;
    (void)hipMemsetAsync((char*)d_ws + WS_CTL, 0, CTL_BYTES, stream);
    Params p{};
    for (int i = 0; i < 26; ++i) p.in[i] = (const float*)d_in[i];
    p.out = (float*)d_out; p.ws = (unsigned char*)d_ws;
#if MK_MULTI
    for (int g = 0; g <= NPH * NL; ++g) { p.gp_lo = g; p.gp_hi = g + 1; hipLaunchKernelGGL(mega, dim3(grid), dim3(512), LDS_BYTES, stream, p); }
#else
    p.gp_lo = 0; p.gp_hi = NPH * NL + 1; hipLaunchKernelGGL(mega, dim3(grid), dim3(512), LDS_BYTES, stream, p);
#endif
}
```
